# Optimizing an MI355X kernel written in HIP

```python
import math
import jax, jax.numpy as jnp
from jax import lax
import numpy as np

D_MODEL = 1024
BATCH = 4
SEQ = 8192
DEPTH = 4

GRID_W = 64
CTX_LEN = 256
S5_GROUP = 16
S5_GROUPS = D_MODEL // S5_GROUP
S5_STATE = 64
S5_DT_MIN = 0.001
S5_DT_MAX = 0.1
GLA_HEADS = 4
GLA_DK = D_MODEL // (2 * GLA_HEADS)
GLA_DV = D_MODEL // GLA_HEADS
GLA_GATE_RANK = 16
GLA_GATE_NORM = 16.0
GLA_CHUNK = 64
N_EXPERTS = 32
TOP_K = 4
EXPERT_FF = D_MODEL
SWIGLU_ALPHA = 1.702
SWIGLU_LIMIT = 7.0
MOE_BLOCK = 128
DN_ALPHA = (2 * DEPTH) ** 0.25
DN_BETA = (8 * DEPTH) ** -0.25
LN_EPS = 1e-5
N_S5_LAYERS = (DEPTH + 1) // 2
N_GLA_LAYERS = DEPTH // 2

kernel_name = 'hybrid_s5_gla_moe_deepnorm_dit'

F32 = jnp.float32


def _layer_norm(x, g, b):
    xf = x.astype(F32)
    mu = jnp.mean(xf, axis=-1, keepdims=True)
    var = jnp.mean(jnp.square(xf - mu), axis=-1, keepdims=True)
    return ((xf - mu) * lax.rsqrt(var + LN_EPS) * g.astype(F32) + b.astype(F32)).astype(x.dtype)


def _modulate(x, shift, scale):
    return x * (1 + scale) + shift


def _s5_discretize(lam_re, lam_im, log_step, b_re, b_im):
    lr = lam_re.astype(F32)
    li = lam_im.astype(F32)
    dt = jnp.exp(log_step.astype(F32))[:, None]
    mag = jnp.exp(lr * dt)
    ar = mag * jnp.cos(li * dt)
    ai = mag * jnp.sin(li * dt)
    den = lr * lr + li * li
    nr = ar - 1.0
    kr = (nr * lr + ai * li) / den
    ki = (ai * lr - nr * li) / den
    br = b_re.astype(F32)
    bi = b_im.astype(F32)
    bbr = kr[..., None] * br - ki[..., None] * bi
    bbi = kr[..., None] * bi + ki[..., None] * br
    return ar, ai, bbr, bbi


def _cplx_affine_op(e1, e2):
    a1r, a1i, b1r, b1i = e1
    a2r, a2i, b2r, b2i = e2
    return (a2r * a1r - a2i * a1i, a2r * a1i + a2i * a1r,
            a2r * b1r - a2i * b1i + b2r, a2r * b1i + a2i * b1r + b2i)


def _s5_scan(u, ar, ai, bbr, bbi, cr, ci, s0, reverse, readout):
    l = u.shape[1]
    bu_re = jnp.einsum('blgh,gph->blgp', u, bbr)
    bu_im = jnp.einsum('blgh,gph->blgp', u, bbi)
    shp = (1, l) + ar.shape
    acc_re, acc_im, s_re, s_im = lax.associative_scan(
        _cplx_affine_op,
        (jnp.broadcast_to(ar, shp), jnp.broadcast_to(ai, shp), bu_re, bu_im),
        reverse=reverse, axis=1)
    if s0 is not None:
        s0r = s0[0][:, None]
        s0i = s0[1][:, None]
        s_re = s_re + acc_re * s0r - acc_im * s0i
        s_im = s_im + acc_re * s0i + acc_im * s0r
    end = 0 if reverse else l - 1
    s_end = (s_re[:, end], s_im[:, end])
    if not readout:
        return None, s_end
    y = jnp.einsum('blgp,ghp->blgh', s_re, cr) - jnp.einsum('blgp,ghp->blgh', s_im, ci)
    return y, s_end


def _s5_glu(y, w_glu):
    d = y.shape[-1]
    z = jax.nn.gelu(y) @ w_glu.astype(F32)
    return z[..., :d] * jax.nn.sigmoid(z[..., d:])


def _s5_mixer(u, uc, lam_re, lam_im, log_step, b_re, b_im, c_re, c_im, d_skip, w_glu, ctx_out):
    bn, l, d = u.shape
    lc = uc.shape[1]
    ul = u.astype(F32)
    ucf = uc.astype(F32)
    dsk = d_skip.astype(F32)
    grp = lambda t: t.reshape(t.shape[0], t.shape[1], S5_GROUPS, S5_GROUP)
    y = dsk * ul
    yc = dsk * ucf if ctx_out else None
    for dr, rev in ((0, False), (1, True)):
        ar, ai, bbr, bbi = _s5_discretize(lam_re[dr], lam_im[dr], log_step[dr], b_re[dr], b_im[dr])
        cr = c_re[dr].astype(F32)
        ci = c_im[dr].astype(F32)
        y_ctx, s_ctx = _s5_scan(grp(ucf), ar, ai, bbr, bbi, cr, ci, None, rev, ctx_out)
        y_lat, _ = _s5_scan(grp(ul), ar, ai, bbr, bbi, cr, ci, s_ctx, rev, True)
        y = y + y_lat.reshape(bn, l, d)
        if ctx_out:
            yc = yc + y_ctx.reshape(bn, lc, d)
    out = _s5_glu(y, w_glu).astype(u.dtype)
    out_c = _s5_glu(yc, w_glu).astype(uc.dtype) if ctx_out else None
    return out, out_c


def _gla_chunked(q, k, v, log_a, s0):
    bn, nh, l, dk = q.shape
    dv = v.shape[-1]
    n = l // GLA_CHUNK
    q = q.reshape(bn, nh, n, GLA_CHUNK, dk)
    k = k.reshape(bn, nh, n, GLA_CHUNK, dk)
    v = v.reshape(bn, nh, n, GLA_CHUNK, dv)
    b = jnp.cumsum(log_a.reshape(bn, nh, n, GLA_CHUNK, dk), axis=3)
    b_end = b[:, :, :, -1:, :]
    q_d = q * jnp.exp(b)
    k_d = k * jnp.exp(-b)
    k_e = k * jnp.exp(b_end - b)
    tri = jnp.tril(jnp.ones((GLA_CHUNK, GLA_CHUNK), dtype=bool))
    att = jnp.where(tri, jnp.einsum('bhnid,bhnjd->bhnij', q_d, k_d), 0.0)
    o = jnp.einsum('bhnij,bhnje->bhnie', att, v)
    u_chunk = jnp.einsum('bhnjd,bhnje->nbhde', k_e, v)
    g_chunk = jnp.moveaxis(jnp.exp(b_end[:, :, :, 0, :]), 2, 0)

    def step(s, inp):
        g, uc = inp
        return s * g[..., None] + uc, s

    s_end, s_prev = lax.scan(step, s0, (g_chunk, u_chunk))
    o = o + jnp.einsum('bhnid,nbhde->bhnie', q_d, s_prev)
    return o.reshape(bn, nh, l, dv), s_end


def _gla_mixer(u, uc, rows, w_in, w_a2, b_a2, norm_g, w_out, ctx_out):
    bn, l, d = u.shape
    u_cm = u.reshape(bn, rows, GRID_W, d).transpose(0, 2, 1, 3).reshape(bn, l, d)
    qk_w = GLA_HEADS * GLA_DK
    v_w = GLA_HEADS * GLA_DV
    splits = np.cumsum([qk_w, qk_w, v_w, v_w, GLA_GATE_RANK])

    def heads(t, hd):
        return t.reshape(t.shape[0], t.shape[1], GLA_HEADS, hd).transpose(0, 2, 1, 3)

    def project(z):
        p = (z @ w_in).astype(F32)
        q, k, v, g, a_f, a_b = jnp.split(p, splits, axis=-1)
        log_a = [heads(jax.nn.log_sigmoid(a @ w_a2[dr].astype(F32) + b_a2[dr].astype(F32)) / GLA_GATE_NORM, GLA_DK)
                 for dr, a in enumerate((a_f, a_b))]
        return heads(q, GLA_DK) * (GLA_DK ** -0.5), heads(k, GLA_DK), heads(v, GLA_DV), g, log_a

    def readout(o, g):
        o = o * lax.rsqrt(jnp.mean(o * o, axis=-1, keepdims=True) + LN_EPS) * norm_g.astype(F32)
        o = o.transpose(0, 2, 1, 3).reshape(g.shape)
        return (o * jax.nn.silu(g)) @ w_out.astype(F32)

    flip = lambda t: jnp.flip(t, axis=2)
    ql, kl, vl, gl, la_l = project(u_cm)
    qc, kc, vc, gc, la_c = project(uc)
    s_zero = jnp.zeros((bn, GLA_HEADS, GLA_DK, GLA_DV), F32)
    oc_f, sc_f = _gla_chunked(qc, kc, vc, la_c[0], s_zero)
    ol_f, _ = _gla_chunked(ql, kl, vl, la_l[0], sc_f)
    oc_b, sc_b = _gla_chunked(flip(qc), flip(kc), flip(vc), flip(la_c[1]), s_zero)
    ol_b, _ = _gla_chunked(flip(ql), flip(kl), flip(vl), flip(la_l[1]), sc_b)
    y = readout(ol_f + flip(ol_b), gl)
    y = y.reshape(bn, GRID_W, rows, d).transpose(0, 2, 1, 3).reshape(bn, l, d).astype(u.dtype)
    y_c = readout(oc_f + flip(oc_b), gc).astype(uc.dtype) if ctx_out else None
    return y, y_c


def _moe(xf, w_router, b_router, w_up, b_up, w_down, b_down):
    t, d = xf.shape
    tk = t * TOP_K
    logits = (xf @ w_router).astype(F32) + b_router.astype(F32)
    top_v, top_i = lax.top_k(logits, TOP_K)
    gate = jax.nn.softmax(top_v, axis=-1)
    e_flat = top_i.reshape(-1)
    tok_flat = jnp.arange(tk, dtype=jnp.int32) // TOP_K
    order = jnp.argsort(e_flat)
    e_s = e_flat[order]
    tok_s = tok_flat[order]
    g_s = gate.reshape(-1)[order]
    counts = jnp.bincount(e_flat, length=N_EXPERTS)
    starts = jnp.cumsum(counts) - counts
    padded = (counts + MOE_BLOCK - 1) // MOE_BLOCK * MOE_BLOCK
    pends = jnp.cumsum(padded)
    pstarts = pends - padded
    dest = pstarts[e_s] + jnp.arange(tk, dtype=jnp.int32) - starts[e_s]
    n_blocks = -(-tk // MOE_BLOCK) + N_EXPERTS
    n_rows = n_blocks * MOE_BLOCK
    x_pad = jnp.zeros((n_rows, d), xf.dtype).at[dest].set(xf[tok_s])
    tok_pad = jnp.zeros((n_rows,), jnp.int32).at[dest].set(tok_s)
    g_pad = jnp.zeros((n_rows,), F32).at[dest].set(g_s)
    blk_e = jnp.minimum(jnp.searchsorted(pends, jnp.arange(n_blocks, dtype=jnp.int32) * MOE_BLOCK, side='right'),
                        N_EXPERTS - 1)

    def expert_block(args):
        xb, e = args
        h = (xb @ w_up[e] + b_up[e]).astype(F32)
        h_glu, h_lin = jnp.split(h, 2, axis=-1)
        h_glu = jnp.minimum(h_glu, SWIGLU_LIMIT)
        h_lin = jnp.clip(h_lin, -SWIGLU_LIMIT, SWIGLU_LIMIT)
        a = h_glu * jax.nn.sigmoid(SWIGLU_ALPHA * h_glu) * (h_lin + 1.0)
        return (a.astype(xb.dtype) @ w_down[e] + b_down[e]).astype(F32)

    y = lax.map(expert_block, (x_pad.reshape(n_blocks, MOE_BLOCK, d), blk_e)).reshape(n_rows, d)
    out = jnp.zeros((t, d), F32).at[tok_pad].add(y * g_pad[:, None])
    return out.astype(xf.dtype)


def setup_inputs(seed: int = 0) -> dict:
    key = jax.random.key(seed)
    ks = iter(jax.random.split(key, 40))
    nrm = lambda shape, scale: jax.random.normal(next(ks), shape, F32) * scale
    d = D_MODEL
    na, nb = N_S5_LAYERS, N_GLA_LAYERS
    g, p, hg = S5_GROUPS, S5_STATE, S5_GROUP
    n_idx = jnp.arange(p, dtype=F32)
    inp = {}
    inp['x'] = nrm((BATCH, SEQ, d), 1.0)
    inp['c'] = nrm((BATCH, d), 1.0)
    inp['ctx'] = nrm((BATCH, CTX_LEN, d), 1.0)
    inp['c_ctx'] = nrm((d,), 1.0)
    inp['w_ada'] = nrm((DEPTH, d, 6 * d), 0.5 * d ** -0.5)
    inp['b_ada'] = nrm((DEPTH, 6 * d), 0.01)
    inp['ln1_g'] = 1.0 + nrm((DEPTH, d), 0.01)
    inp['ln1_b'] = nrm((DEPTH, d), 0.01)
    inp['ln2_g'] = 1.0 + nrm((DEPTH, d), 0.01)
    inp['ln2_b'] = nrm((DEPTH, d), 0.01)
    inp['s5_lam_re'] = -0.5 + nrm((na, 2, g, p), 0.01)
    inp['s5_lam_im'] = math.pi * n_idx + nrm((na, 2, g, p), 0.01)
    inp['s5_log_step'] = jax.random.uniform(next(ks), (na, 2, g), F32, math.log(S5_DT_MIN), math.log(S5_DT_MAX))
    inp['s5_b_re'] = nrm((na, 2, g, p, hg), (2 * hg) ** -0.5)
    inp['s5_b_im'] = nrm((na, 2, g, p, hg), (2 * hg) ** -0.5)
    inp['s5_c_re'] = nrm((na, 2, g, hg, p), p ** -0.5)
    inp['s5_c_im'] = nrm((na, 2, g, hg, p), p ** -0.5)
    inp['s5_d'] = nrm((na, d), 1.0)
    inp['s5_w_glu'] = jnp.concatenate([nrm((na, d, d), DN_BETA * d ** -0.5), nrm((na, d, d), d ** -0.5)], axis=-1)
    in_w = 2 * GLA_HEADS * GLA_DK + 2 * GLA_HEADS * GLA_DV + 2 * GLA_GATE_RANK
    inp['gla_w_in'] = nrm((nb, d, in_w), d ** -0.5)
    inp['gla_w_a2'] = nrm((nb, 2, GLA_GATE_RANK, GLA_HEADS * GLA_DK), GLA_GATE_RANK ** -0.5)
    inp['gla_b_a2'] = nrm((nb, 2, GLA_HEADS * GLA_DK), 0.1)
    inp['gla_norm_g'] = 1.0 + nrm((nb, GLA_DV), 0.01)
    inp['gla_w_out'] = nrm((nb, d, d), DN_BETA * d ** -0.5)
    inp['moe_w_router'] = nrm((DEPTH, d, N_EXPERTS), d ** -0.5)
    inp['moe_b_router'] = nrm((DEPTH, N_EXPERTS), 0.01)
    inp['moe_w_up'] = nrm((DEPTH, N_EXPERTS, d, 2 * EXPERT_FF), d ** -0.5)
    inp['moe_b_up'] = nrm((DEPTH, N_EXPERTS, 2 * EXPERT_FF), 0.01)
    inp['moe_w_down'] = nrm((DEPTH, N_EXPERTS, EXPERT_FF, d), DN_BETA * EXPERT_FF ** -0.5)
    inp['moe_b_down'] = nrm((DEPTH, N_EXPERTS, d), 0.01)
    return inp


def reference(x, c, ctx, c_ctx, w_ada, b_ada, ln1_g, ln1_b, ln2_g, ln2_b,
              s5_lam_re, s5_lam_im, s5_log_step, s5_b_re, s5_b_im, s5_c_re, s5_c_im, s5_d, s5_w_glu,
              gla_w_in, gla_w_a2, gla_b_a2, gla_norm_g, gla_w_out,
              moe_w_router, moe_b_router, moe_w_up, moe_b_up, moe_w_down, moe_b_down):
    bn, l, d = x.shape
    lc = ctx.shape[1]
    rows = l // GRID_W
    cond = jax.nn.silu(c)
    cond_ctx = jax.nn.silu(c_ctx)[None]
    h, hc = x, ctx
    for i in range(DEPTH):
        keep_ctx = i < DEPTH - 1
        sh1, sc1, g1, sh2, sc2, g2 = [m[:, None, :] for m in jnp.split(cond @ w_ada[i] + b_ada[i], 6, axis=-1)]
        sh1c, sc1c, g1c, sh2c, sc2c, g2c = [m[:, None, :] for m in jnp.split(cond_ctx @ w_ada[i] + b_ada[i], 6, axis=-1)]
        u = _modulate(h, sh1, sc1)
        uc = _modulate(hc, sh1c, sc1c)
        j = i // 2
        if i % 2 == 0:
            y, yc = _s5_mixer(u, uc, s5_lam_re[j], s5_lam_im[j], s5_log_step[j], s5_b_re[j], s5_b_im[j],
                              s5_c_re[j], s5_c_im[j], s5_d[j], s5_w_glu[j], keep_ctx)
        else:
            y, yc = _gla_mixer(u, uc, rows, gla_w_in[j], gla_w_a2[j], gla_b_a2[j], gla_norm_g[j],
                               gla_w_out[j], keep_ctx)
        h = _layer_norm(DN_ALPHA * h + g1 * y, ln1_g[i], ln1_b[i])
        u2 = _modulate(h, sh2, sc2).reshape(bn * l, d)
        if keep_ctx:
            hc = _layer_norm(DN_ALPHA * hc + g1c * yc, ln1_g[i], ln1_b[i])
            u2c = _modulate(hc, sh2c, sc2c).reshape(bn * lc, d)
            tokens = jnp.concatenate([u2, u2c], axis=0)
        else:
            tokens = u2
        f = _moe(tokens, moe_w_router[i], moe_b_router[i], moe_w_up[i], moe_b_up[i], moe_w_down[i], moe_b_down[i])
        h = _layer_norm(DN_ALPHA * h + g2 * f[:bn * l].reshape(bn, l, d), ln2_g[i], ln2_b[i])
        if keep_ctx:
            hc = _layer_norm(DN_ALPHA * hc + g2c * f[bn * l:].reshape(bn, lc, d), ln2_g[i], ln2_b[i])
    return h
```

```cpp
#include <hip/hip_runtime.h>
#include <cstdio>
#include <cstdint>

#define LAS __attribute__((address_space(3)))
#define GBL __attribute__((address_space(1)))
#define DI __device__ __forceinline__
typedef unsigned short bf16_t;
typedef short bf16x8 __attribute__((ext_vector_type(8)));
typedef short s16x4 __attribute__((ext_vector_type(4)));
typedef float f32x4 __attribute__((ext_vector_type(4)));
typedef float f32x16 __attribute__((ext_vector_type(16)));
typedef unsigned u32x4 __attribute__((ext_vector_type(4)));
typedef unsigned u32x2 __attribute__((ext_vector_type(2)));

constexpr int D = 1024, NB = 4, SEQ = 8192, LCTX = 256, DEPTH = 4;
constexpr int TL = NB * SEQ, TC = NB * LCTX, TT = TL + TC;
constexpr int NTHR = 512;
constexpr int S5T = 32;
constexpr int S5ROWS = 1280;
constexpr int S5VALID = 1056;
constexpr int NEXP = 32, TOPK = 4;
constexpr int ACT_ROWS = TT * TOPK + NEXP * 256;
constexpr float DN_ALPHA = 1.6817928305074292f;
constexpr float LN_EPS = 1e-5f;
constexpr int LDS_BYTES = 147456;
constexpr int LDS_MISC = LDS_BYTES - 1024;

constexpr size_t al256(size_t x) { return (x + 255) & ~(size_t)255; }
constexpr size_t CTL_BYTES = 131072;
constexpr size_t WS_CTL   = 0;
constexpr size_t WS_MOD   = WS_CTL + CTL_BYTES;
constexpr size_t WS_H     = al256(WS_MOD + (size_t)DEPTH * 5 * 6144 * 4);
constexpr size_t WS_UB    = al256(WS_H + (size_t)TT * D * 4);
constexpr size_t WS_UP    = al256(WS_UB + (size_t)TT * D * 2);
constexpr size_t WS_E     = al256(WS_UP + (size_t)64 * S5ROWS * 768 * 2);
constexpr size_t WS_YG    = al256(WS_E + (size_t)64 * S5ROWS * 256 * 4);
constexpr size_t WS_P     = al256(WS_YG + (size_t)TT * D * 2);
constexpr size_t WS_ALR   = al256(WS_P + (size_t)TT * 3072 * 2);
constexpr size_t WS_QKE   = al256(WS_ALR + (size_t)TT * 32 * 4);
constexpr size_t WS_GCH   = al256(WS_QKE + (size_t)6 * TT * 512 * 2);
constexpr size_t WS_O     = al256(WS_GCH + (size_t)528 * 2 * 512 * 4);
constexpr size_t WS_TOKL  = al256(WS_O + (size_t)2 * TT * D * 2);
constexpr size_t WS_GATEL = al256(WS_TOKL + (size_t)NEXP * TT * 4);
constexpr size_t WS_ACT   = al256(WS_GATEL + (size_t)NEXP * TT * 4);
constexpr size_t WS_FEXP  = al256(WS_ACT + (size_t)ACT_ROWS * D * 2);
constexpr size_t WS_WGLU  = al256(WS_FEXP + (size_t)TT * 4 * D * 2);
constexpr size_t WS_WIN   = al256(WS_WGLU + (size_t)2 * 2048 * D * 2);
constexpr size_t WS_WOUT  = al256(WS_WIN + (size_t)2 * 3072 * D * 2);
constexpr size_t WS_WUP   = al256(WS_WOUT + (size_t)2 * D * D * 2);
constexpr size_t WS_WDN   = al256(WS_WUP + (size_t)DEPTH * NEXP * 2048 * D * 2);
constexpr size_t WS_WR    = al256(WS_WDN + (size_t)DEPTH * NEXP * D * D * 2);
constexpr size_t WS_WLR   = al256(WS_WR + (size_t)DEPTH * 32 * D * 2);
constexpr size_t WS_S5M   = al256(WS_WLR + (size_t)2 * 32 * D * 2);
constexpr size_t WS_S5PIN = al256(WS_S5M + (size_t)2 * 64 * 512 * 768 * 2);
constexpr size_t WS_S5AT  = al256(WS_S5PIN + (size_t)2 * 64 * 256 * 512 * 2);
constexpr size_t WS_END   = al256(WS_S5AT + (size_t)2 * 64 * 2 * 64 * 2 * 4);

#define CW_QUEUE 3520
#define CW_CNT   3584

#define XB_TMO      128
#define XB_XCNT(j)  (256  + 64 * (j))
#define XB_XSUB(j)  (1280 + 64 * (j))
#define XB_XGEN(j)  (2304 + 64 * (j))
#define XB_TOP      3328
#define XB_TOPGEN   3392
#define XCD_BAR_WORDS 3456
#define XB_SPIN_CAP (1u << 18)

__device__ __forceinline__ unsigned xb_ld(unsigned* p)              { return __hip_atomic_load(p, __ATOMIC_RELAXED, __HIP_MEMORY_SCOPE_AGENT); }
__device__ __forceinline__ unsigned xb_add(unsigned* p, unsigned v) { return __hip_atomic_fetch_add(p, v, __ATOMIC_RELAXED, __HIP_MEMORY_SCOPE_AGENT); }
__device__ __forceinline__ unsigned xb_xcc_id() { return (unsigned)__builtin_amdgcn_s_getreg((3 << 11) | 20) & 0xFu; }
#define XB_SPIN(cond, bar) do { unsigned _sp = 0; while (cond) { __builtin_amdgcn_s_sleep(1); \
    if ((++_sp & 255u) == 0u) { if (xb_ld(&(bar)[XB_TMO])) break; if (_sp > XB_SPIN_CAP) { atomicAdd(&(bar)[XB_TMO], 1u); break; } } } } while (0)

struct XcdBarrier { unsigned* bar; unsigned x; volatile LAS unsigned* st; };

__device__ __forceinline__ XcdBarrier xcd_barrier_post(unsigned* bar, volatile LAS unsigned* st) {
    XcdBarrier b; b.bar = bar; b.x = xb_xcc_id(); b.st = st;
    if (threadIdx.x == 0) (void)xb_add(&bar[XB_XCNT(b.x)], 1u);
    return b;
}
__device__ __forceinline__ void xcd_barrier_complete(unsigned* bar, unsigned x, unsigned& nloc, unsigned& nx) {
    const unsigned G = gridDim.x * gridDim.y * gridDim.z;
    unsigned sum, cnt, mine, sp = 0u;
    for (;;) {
        sum = 0u; cnt = 0u; mine = 0u;
#pragma unroll
        for (unsigned j = 0; j < 16; ++j) { const unsigned c = xb_ld(&bar[XB_XCNT(j)]); sum += c; cnt += (c > 0u) ? 1u : 0u; mine = (j == x) ? c : mine; }
        if (sum == G) break;
        __builtin_amdgcn_s_sleep(1);
        if ((++sp & 255u) == 0u) { if (xb_ld(&bar[XB_TMO])) break; if (sp > XB_SPIN_CAP) { atomicAdd(&bar[XB_TMO], 1u); break; } }
    }
    nloc = mine > 0u ? mine : 1u; nx = cnt > 0u ? cnt : 1u;
}
__device__ __forceinline__ void xcd_barrier(const XcdBarrier& b) {
    asm volatile("s_waitcnt vmcnt(0)" ::: "memory");
    __syncthreads();
    if (threadIdx.x == 0) {
        unsigned* bar = b.bar;
        __builtin_amdgcn_s_waitcnt(0);
        unsigned nloc = b.st[0], nx = b.st[1];
        if (nloc == 0u) { xcd_barrier_complete(bar, b.x, nloc, nx); b.st[0] = nloc; b.st[1] = nx; }
        const unsigned old = xb_add(&bar[XB_XSUB(b.x)], 1u);
        const unsigned gen = old / nloc;
        if (old + 1u == (gen + 1u) * nloc) {
            __builtin_amdgcn_fence(__ATOMIC_RELEASE, "agent");
            asm volatile("s_waitcnt vmcnt(0)" ::: "memory");
            const unsigned og = xb_add(&bar[XB_TOP], 1u);
            const unsigned tg = og / nx;
            if (og + 1u == (tg + 1u) * nx) xb_add(&bar[XB_TOPGEN], 1u);
            else XB_SPIN(xb_ld(&bar[XB_TOPGEN]) == tg, bar);
            __builtin_amdgcn_fence(__ATOMIC_ACQUIRE, "agent");
            xb_add(&bar[XB_XGEN(b.x)], 1u);
            asm volatile("s_waitcnt vmcnt(0)" ::: "memory");
        } else {
            XB_SPIN(xb_ld(&bar[XB_XGEN(b.x)]) == gen, bar);
            __builtin_amdgcn_fence(__ATOMIC_ACQUIRE, "agent");
            asm volatile("s_waitcnt vmcnt(0)" ::: "memory");
        }
    }
    __syncthreads();
}

typedef float f32x2_t __attribute__((ext_vector_type(2)));
typedef __bf16 bf16x2_t __attribute__((ext_vector_type(2)));
DI unsigned cvt_pk_bf16(float lo, float hi) { f32x2_t v; v.x = lo; v.y = hi; return __builtin_bit_cast(unsigned, __builtin_convertvector(v, bf16x2_t)); }
DI float bf_lo(unsigned u) { return __uint_as_float(u << 16); }
DI float bf_hi(unsigned u) { return __uint_as_float(u & 0xffff0000u); }
DI float bf2f(bf16_t b) { return __uint_as_float(((unsigned)b) << 16); }
DI bf16_t f2bf(float f) { return (bf16_t)(cvt_pk_bf16(f, 0.f) & 0xffffu); }
DI float wave_sum(float v) {
#pragma unroll
    for (int m = 32; m >= 1; m >>= 1) v += __shfl_xor(v, m, 64);
    return v;
}
DI float sigmoidf_(float x) { return 1.0f / (1.0f + __expf(-x)); }
DI float gelu_tanh(float x) { const float z = 0.7978845608028654f * (x + 0.044715f * x * x * x); const float t = 1.0f - 2.0f / (__expf(2.0f * z) + 1.0f); return 0.5f * x * (1.0f + t); }
DI int perm32(int rho) { return 8 * ((rho >> 2) & 3) + 4 * (rho >> 4) + (rho & 3); }
DI int inv32(int o) { return 16 * ((o >> 2) & 1) + 4 * (o >> 3) + (o & 3); }

namespace g8 {
constexpr int BM = 256, BK = 64, HALF = 128, HTB = HALF * BK * 2, STAGE_BYTES = 8 * HTB;
DI int lds_byte(int r, int c) { const int st = (r >> 4) * 2 + (c >> 5), rr = r & 15, cc = c & 31, ob = rr * 64 + cc * 2; return st * 1024 + (ob ^ (((ob >> 9) & 1) << 5)); }
DI void stage_rc(int b, int& R, int& C) { const int st = b / 1024, sb = b % 1024, swz = sb ^ (((sb >> 9) & 1) << 5); R = (st >> 1) * 16 + swz / 64; C = (st & 1) * 32 + (swz % 64) / 2; }

typedef f32x4 Acc[2][2][4][2];

template <class P>
DI void gemm_phase(LAS unsigned char* lds, const int tid, P& prob) {
    const int wid = __builtin_amdgcn_readfirstlane(tid >> 6), lane = tid & 63, wr = wid >> 2, wc = wid & 3, fr = lane & 15, fq = lane >> 4;
    const int K = prob.K(), nt = K / BK, lda = prob.lda(), ldb = prob.ldb();
    unsigned cvA[2][2], nvA[2][2], voffB[2];
#pragma unroll
    for (int i = 0; i < 2; ++i) { int R, C; stage_rc(tid * 16 + i * 8192, R, C);
        voffB[i] = (unsigned)(R * ldb + C) * 2u;
        cvA[0][i] = (unsigned)(R * lda + C) * 2u; cvA[1][i] = (unsigned)((R + HALF) * lda + C) * 2u;
        nvA[0][i] = cvA[0][i]; nvA[1][i] = cvA[1][i]; }
    const size_t kstep = (size_t)(BK * 2);
    const size_t hstepB = (size_t)HALF * ldb * 2;
    const unsigned ldsw = (unsigned)wid * 1024u;
    const int aoff = lds_byte(wr * 64 + fr, fq * 8), boff = lds_byte(wc * 32 + fr, fq * 8);
#define G8_SA(b, h) (((b) * 2 + (h)) * HTB)
#define G8_SB(b, h) ((4 + (b) * 2 + (h)) * HTB)
#define G8_STAGE(bufoff, gbase, voff) do { _Pragma("unroll") for (int _i = 0; _i < 2; ++_i) \
        __builtin_amdgcn_global_load_lds((const unsigned*)((const char*)(gbase) + (voff)[_i]), (LAS unsigned*)(lds + (bufoff) + ldsw + _i * 8192), 16, 0, 0); } while (0)
#define G8_STAGE_SEL(bufoff, gbase, h, sel) do { _Pragma("unroll") for (int _i = 0; _i < 2; ++_i) { const unsigned _vo = (P::GATHER && (sel)) ? nvA[h][_i] : cvA[h][_i]; \
        __builtin_amdgcn_global_load_lds((const unsigned*)((const char*)(gbase) + _vo), (LAS unsigned*)(lds + (bufoff) + ldsw + _i * 8192), 16, 0, 0); } } while (0)
#define G8_LDA(dst, b, h) do { _Pragma("unroll") for (int m = 0; m < 4; ++m) _Pragma("unroll") for (int k = 0; k < 2; ++k) dst[m][k] = *(const LAS bf16x8*)(lds + G8_SA(b, h) + aoff + m * 2048 + k * 1024); } while (0)
#define G8_LDB(dst, b, h) do { _Pragma("unroll") for (int n = 0; n < 2; ++n) _Pragma("unroll") for (int k = 0; k < 2; ++k) dst[n][k] = *(const LAS bf16x8*)(lds + G8_SB(b, h) + boff + n * 2048 + k * 1024); } while (0)
#define G8_MMA(ai, bj, At, Bt) do { __builtin_amdgcn_s_setprio(1); _Pragma("unroll") for (int m = 0; m < 4; ++m) _Pragma("unroll") for (int n = 0; n < 2; ++n) _Pragma("unroll") for (int k = 0; k < 2; ++k) \
        acc[ai][bj][m][n] = __builtin_amdgcn_mfma_f32_16x16x32_bf16(Bt[n][k], At[m][k], acc[ai][bj][m][n], 0, 0, 0); __builtin_amdgcn_s_setprio(0); } while (0)
#define G8_WAIT_V(n) asm volatile("s_waitcnt vmcnt(" #n ")" ::: "memory")
#define G8_WAIT_L(n) asm volatile("s_waitcnt lgkmcnt(" #n ")" ::: "memory")
#define G8_BAR __builtin_amdgcn_s_barrier()
#define G8_SCHED __builtin_amdgcn_sched_barrier(0)
    typename P::Unit cur, nxt; int ui = 0;
    if (!prob.next(0, cur)) return;
    Acc acc;
#pragma unroll
    for (int a = 0; a < 2; ++a)
#pragma unroll
        for (int b = 0; b < 2; ++b)
#pragma unroll
            for (int m = 0; m < 4; ++m)
#pragma unroll
                for (int n = 0; n < 2; ++n) acc[a][b][m][n] = (f32x4){0.f, 0.f, 0.f, 0.f};
    bf16x8 At[4][2], B0[2][2], B1[2][2];
    const char* cA = cur.a; const char* cB = cur.b;
    if (P::GATHER) prob.gather(cur, tid, cvA);
    G8_STAGE(G8_SB(0, 0), cB, voffB); G8_STAGE(G8_SA(0, 0), cA, cvA[0]); G8_STAGE(G8_SB(0, 1), cB + hstepB, voffB); G8_STAGE(G8_SA(0, 1), cA, cvA[1]);
    if (wr == 1) G8_BAR;
    G8_WAIT_V(4); G8_BAR;
    G8_STAGE(G8_SB(1, 0), cB + kstep, voffB); G8_STAGE(G8_SA(1, 0), cA + kstep, cvA[0]); G8_STAGE(G8_SB(1, 1), cB + hstepB + kstep, voffB);
    G8_WAIT_V(6); G8_BAR;
    for (;;) {
        const bool has_next = prob.next(ui + 1, nxt);
        const char* nA = has_next ? nxt.a : cA; const char* nB = has_next ? nxt.b : cB;
        if (P::GATHER) { if (has_next) prob.gather(nxt, tid, nvA); else {
#pragma unroll
            for (int h = 0; h < 2; ++h)
#pragma unroll
                for (int i = 0; i < 2; ++i) nvA[h][i] = cvA[h][i]; } }
        for (int t = 0; t < nt; t += 2) {
            const bool last = (t == nt - 2);
            const char* a1 = cA + (size_t)(t + 1) * kstep;
            const char* a2 = last ? nA : cA + (size_t)(t + 2) * kstep; const char* b2 = last ? nB : cB + (size_t)(t + 2) * kstep;
            const char* a3 = a2 + kstep; const char* b3 = b2 + kstep;
            G8_LDB(B0, 0, 0); G8_SCHED; G8_LDA(At, 0, 0); G8_STAGE(G8_SA(1, 1), a1, cvA[1]);
            G8_WAIT_L(8); G8_BAR; G8_WAIT_L(0); G8_MMA(0, 0, At, B0); G8_BAR; G8_SCHED;
            G8_LDB(B1, 0, 1); G8_STAGE(G8_SB(0, 0), b2, voffB);
            G8_BAR; G8_WAIT_L(0); G8_MMA(0, 1, At, B1); G8_BAR;
            G8_LDA(At, 0, 1); G8_STAGE_SEL(G8_SA(0, 0), a2, 0, last);
            G8_BAR; G8_WAIT_L(0); G8_MMA(1, 0, At, B0); G8_BAR; G8_SCHED;
            G8_STAGE(G8_SB(0, 1), b2 + hstepB, voffB);
            G8_WAIT_V(6); G8_BAR; G8_MMA(1, 1, At, B1); G8_BAR;
            G8_LDB(B0, 1, 0); G8_SCHED; G8_LDA(At, 1, 0); G8_STAGE_SEL(G8_SA(0, 1), a2, 1, last);
            G8_WAIT_L(8); G8_BAR; G8_WAIT_L(0); G8_MMA(0, 0, At, B0); G8_BAR; G8_SCHED;
            G8_LDB(B1, 1, 1); G8_STAGE(G8_SB(1, 0), b3, voffB);
            G8_BAR; G8_WAIT_L(0); G8_MMA(0, 1, At, B1); G8_BAR;
            G8_LDA(At, 1, 1); G8_STAGE_SEL(G8_SA(1, 0), a3, 0, last);
            G8_BAR; G8_WAIT_L(0); G8_MMA(1, 0, At, B0); G8_BAR; G8_SCHED;
            G8_STAGE(G8_SB(1, 1), b3 + hstepB, voffB);
            G8_WAIT_V(6); G8_BAR; G8_MMA(1, 1, At, B1); G8_BAR;
        }
        prob.epi(acc, cur, wr, wc, fr, fq);
        if (!has_next) break;
#pragma unroll
        for (int a = 0; a < 2; ++a)
#pragma unroll
            for (int b = 0; b < 2; ++b)
#pragma unroll
                for (int m = 0; m < 4; ++m)
#pragma unroll
                    for (int n = 0; n < 2; ++n) acc[a][b][m][n] = (f32x4){0.f, 0.f, 0.f, 0.f};
        cur = nxt; cA = nA; cB = nB; ++ui;
        if (P::GATHER) {
#pragma unroll
            for (int h = 0; h < 2; ++h)
#pragma unroll
                for (int i = 0; i < 2; ++i) cvA[h][i] = nvA[h][i]; }
    }
    G8_WAIT_V(0);
    if (wr == 0) G8_BAR;
    G8_BAR;
#undef G8_SA
#undef G8_SB
#undef G8_STAGE
#undef G8_STAGE_SEL
#undef G8_LDA
#undef G8_LDB
#undef G8_MMA
#undef G8_WAIT_V
#undef G8_WAIT_L
#undef G8_BAR
#undef G8_SCHED
}
}

struct Args { const float* in[30]; float* out; unsigned char* ws; };
typedef const float* fptr_t;
typedef __attribute__((address_space(4))) const fptr_t* inarr_t;
struct Frame {
    LAS unsigned char* lds; unsigned char* ws; inarr_t in; float* out;
    int tid, lane, wave, G, vcu;
    DI const float* inp(int i) const { return (const float*)(const GBL float*)in[i]; }
};
DI Frame launder(const Frame& F0) {
    Frame F = F0;
    { unsigned long long x = (unsigned long long)F.ws; asm volatile("" : "+s"(x)); F.ws = (unsigned char*)(GBL unsigned char*)x; }
    { unsigned long long x = (unsigned long long)F.out; asm volatile("" : "+s"(x)); F.out = (float*)(GBL float*)x; }
    asm volatile("" : "+s"(F.in));
    asm volatile("" : "+v"(F.tid)); F.lane = F.tid & 63; F.wave = __builtin_amdgcn_readfirstlane(F.tid >> 6);
    asm volatile("" : "+s"(F.G)); asm volatile("" : "+s"(F.vcu));
    return F;
}
enum { I_X = 0, I_C, I_CTX, I_CCTX, I_WADA, I_BADA, I_LN1G, I_LN1B, I_LN2G, I_LN2B, I_LAMRE, I_LAMIM, I_LOGSTEP, I_BRE, I_BIM, I_CRE, I_CIM, I_S5D, I_WGLU,
       I_WIN, I_WA2, I_BA2, I_NORMG, I_WOUT, I_WROUTER, I_BROUTER, I_WUP, I_BUP, I_WDN, I_BDN };

DI const float* modp(const Frame& F, int layer, int b, int which) { return (const float*)(F.ws + WS_MOD) + ((size_t)(layer * 5 + b) * 6 + which) * 1024; }

struct ProbS5E {
    static constexpr bool GATHER = false;
    struct Unit { const char* a; const char* b; int g, rt; };
    const bf16_t* UP; const bf16_t* PIN; float* E; int G, vcu;
    DI int K() const { return 512; } DI int lda() const { return 768; } DI int ldb() const { return 512; }
    DI bool next(int i, Unit& u) const {
        const int L = i * G + vcu; if (L >= 64 * 5) return false;
        u.g = L / 5; u.rt = L % 5;
        u.a = (const char*)(UP + ((size_t)u.g * S5ROWS + u.rt * 256) * 768); u.b = (const char*)(PIN + (size_t)u.g * 256 * 512); return true; }
    DI void gather(const Unit&, int, unsigned (&)[2][2]) const {}
    DI void epi(const g8::Acc& acc, const Unit& u, int wr, int wc, int fr, int fq) const {
#pragma unroll
        for (int ai = 0; ai < 2; ++ai)
#pragma unroll
            for (int m = 0; m < 4; ++m) {
                const int row = u.rt * 256 + ai * 128 + wr * 64 + m * 16 + fr;
                float* rowp = E + ((size_t)u.g * S5ROWS + row) * 256 + wc * 32 + fq * 8;
#pragma unroll
                for (int bj = 0; bj < 2; ++bj) { *(f32x4*)(rowp + bj * 128) = acc[ai][bj][m][0]; *(f32x4*)(rowp + bj * 128 + 4) = acc[ai][bj][m][1]; }
            }
    }
};
struct ProbS5Y {
    static constexpr bool GATHER = false;
    struct Unit { const char* a; const char* b; int g, rt, pn; };
    const bf16_t* UP; const bf16_t* M; bf16_t* YG; int G, vcu;
    DI int K() const { return 768; } DI int lda() const { return 768; } DI int ldb() const { return 768; }
    DI bool next(int i, Unit& u) const {
        const int L = i * G + vcu; if (L >= 64 * 5 * 2) return false;
        u.pn = L & 1; u.rt = (L >> 1) % 5; u.g = L / 10;
        u.a = (const char*)(UP + ((size_t)u.g * S5ROWS + u.rt * 256) * 768); u.b = (const char*)(M + ((size_t)u.g * 512 + u.pn * 256) * 768); return true; }
    DI void gather(const Unit&, int, unsigned (&)[2][2]) const {}
    DI void epi(const g8::Acc& acc, const Unit& u, int wr, int wc, int fr, int fq) const {
#pragma unroll
        for (int ai = 0; ai < 2; ++ai)
#pragma unroll
            for (int m = 0; m < 4; ++m) {
                const int cr = u.rt * 256 + ai * 128 + wr * 64 + m * 16 + fr;
                if (cr < S5VALID) {
                    const int tokbase = cr < 1024 ? (cr >> 8) * SEQ + (cr & 255) * S5T : TL + (cr - 1024) * S5T;
#pragma unroll
                    for (int bj = 0; bj < 2; ++bj) {
                        const int c = u.pn * 256 + bj * 128 + wc * 32 + fq * 8;
                        const int t = c >> 4, h0 = c & 15;
                        const f32x4 v0 = acc[ai][bj][m][0], v1 = acc[ai][bj][m][1];
                        u32x4 o; o[0] = cvt_pk_bf16(gelu_tanh(v0[0]), gelu_tanh(v0[1])); o[1] = cvt_pk_bf16(gelu_tanh(v0[2]), gelu_tanh(v0[3]));
                        o[2] = cvt_pk_bf16(gelu_tanh(v1[0]), gelu_tanh(v1[1])); o[3] = cvt_pk_bf16(gelu_tanh(v1[2]), gelu_tanh(v1[3]));
                        *(u32x4*)(YG + (size_t)(tokbase + t) * D + u.g * 16 + h0) = o;
                    }
                }
            }
    }
};
struct ProbGLU {
    static constexpr bool GATHER = false;
    struct Unit { const char* a; const char* b; int rt, pn; };
    const bf16_t* A; const bf16_t* W; float* H; const float* mod_g1_base;   int G, vcu;
    DI int K() const { return 1024; } DI int lda() const { return 1024; } DI int ldb() const { return 1024; }
    DI bool next(int i, Unit& u) const {
        const int L = i * G + vcu; if (L >= (TT / 256) * 8) return false;
        u.pn = L & 7; u.rt = L >> 3;
        u.a = (const char*)(A + (size_t)u.rt * 256 * 1024); u.b = (const char*)(W + (size_t)u.pn * 256 * 1024); return true; }
    DI void gather(const Unit&, int, unsigned (&)[2][2]) const {}
    DI void epi(const g8::Acc& acc, const Unit& u, int wr, int wc, int fr, int fq) const {
        const int row0 = u.rt * 256; const int b = row0 < TL ? (row0 >> 13) : 4;
        const int c = u.pn * 128 + wc * 32 + fq * 8;
        const float* g1p = mod_g1_base + (size_t)b * 6144 + 2 * 1024 + c;
        const f32x4 g1a = *(const f32x4*)g1p, g1b = *(const f32x4*)(g1p + 4);
#pragma unroll
        for (int ai = 0; ai < 2; ++ai)
#pragma unroll
            for (int m = 0; m < 4; ++m) {
                const int row = row0 + ai * 128 + wr * 64 + m * 16 + fr;
                float* hp = H + (size_t)row * D + c;
                f32x4 h0 = *(f32x4*)hp, h1 = *(f32x4*)(hp + 4);
                const f32x4 va = acc[ai][0][m][0], vb = acc[ai][0][m][1], ga = acc[ai][1][m][0], gb = acc[ai][1][m][1];
#pragma unroll
                for (int i = 0; i < 4; ++i) { h0[i] = DN_ALPHA * h0[i] + g1a[i] * (va[i] * sigmoidf_(ga[i])); h1[i] = DN_ALPHA * h1[i] + g1b[i] * (vb[i] * sigmoidf_(gb[i])); }
                *(f32x4*)hp = h0; *(f32x4*)(hp + 4) = h1;
            }
    }
};
struct ProbProj {
    static constexpr bool GATHER = false;
    struct Unit { const char* a; const char* b; int rt, pn; };
    const bf16_t* A; const bf16_t* W; bf16_t* P; int G, vcu;
    DI int K() const { return 1024; } DI int lda() const { return 1024; } DI int ldb() const { return 1024; }
    DI bool next(int i, Unit& u) const {
        const int L = i * G + vcu; if (L >= (TT / 256) * 12) return false;
        u.pn = L % 12; u.rt = L / 12;
        u.a = (const char*)(A + (size_t)u.rt * 256 * 1024); u.b = (const char*)(W + (size_t)u.pn * 256 * 1024); return true; }
    DI void gather(const Unit&, int, unsigned (&)[2][2]) const {}
    DI void epi(const g8::Acc& acc, const Unit& u, int wr, int wc, int fr, int fq) const {
#pragma unroll
        for (int ai = 0; ai < 2; ++ai)
#pragma unroll
            for (int m = 0; m < 4; ++m) {
                const int row = u.rt * 256 + ai * 128 + wr * 64 + m * 16 + fr;
#pragma unroll
                for (int bj = 0; bj < 2; ++bj) {
                    const int c = u.pn * 256 + bj * 128 + wc * 32 + fq * 8;
                    const f32x4 v0 = acc[ai][bj][m][0], v1 = acc[ai][bj][m][1];
                    u32x4 o; o[0] = cvt_pk_bf16(v0[0], v0[1]); o[1] = cvt_pk_bf16(v0[2], v0[3]); o[2] = cvt_pk_bf16(v1[0], v1[1]); o[3] = cvt_pk_bf16(v1[2], v1[3]);
                    *(u32x4*)(P + (size_t)row * 3072 + c) = o;
                }
            }
    }
};
struct ProbOut {
    static constexpr bool GATHER = false;
    struct Unit { const char* a; const char* b; int rt, pn; };
    const bf16_t* A; const bf16_t* W; float* H; const float* mod_g1_base; int nrt; int G, vcu;
    DI int K() const { return 1024; } DI int lda() const { return 1024; } DI int ldb() const { return 1024; }
    DI bool next(int i, Unit& u) const {
        const int L = i * G + vcu; if (L >= nrt * 4) return false;
        u.pn = L & 3; u.rt = L >> 2;
        u.a = (const char*)(A + (size_t)u.rt * 256 * 1024); u.b = (const char*)(W + (size_t)u.pn * 256 * 1024); return true; }
    DI void gather(const Unit&, int, unsigned (&)[2][2]) const {}
    DI void epi(const g8::Acc& acc, const Unit& u, int wr, int wc, int fr, int fq) const {
        const int row0 = u.rt * 256; const int b = row0 < TL ? (row0 >> 13) : 4;
#pragma unroll
        for (int ai = 0; ai < 2; ++ai)
#pragma unroll
            for (int m = 0; m < 4; ++m) {
                const int r = row0 + ai * 128 + wr * 64 + m * 16 + fr;
                int tok = r;
                if (r < TL) { const int np = r & 8191; tok = (r & ~8191) + (np & 127) * 64 + (np >> 7); }
#pragma unroll
                for (int bj = 0; bj < 2; ++bj) {
                    const int c = u.pn * 256 + bj * 128 + wc * 32 + fq * 8;
                    const float* g1p = mod_g1_base + (size_t)b * 6144 + 2 * 1024 + c;
                    const f32x4 g1a = *(const f32x4*)g1p, g1b = *(const f32x4*)(g1p + 4);
                    float* hp = H + (size_t)tok * D + c;
                    f32x4 h0 = *(f32x4*)hp, h1 = *(f32x4*)(hp + 4);
                    const f32x4 va = acc[ai][bj][m][0], vb = acc[ai][bj][m][1];
#pragma unroll
                    for (int i = 0; i < 4; ++i) { h0[i] = DN_ALPHA * h0[i] + g1a[i] * va[i]; h1[i] = DN_ALPHA * h1[i] + g1b[i] * vb[i]; }
                    *(f32x4*)hp = h0; *(f32x4*)(hp + 4) = h1;
                }
            }
    }
};
struct MoeTab { const LAS int* t; DI int cnt(int e) const { return t[e]; } DI int tpre(int e) const { return t[32 + e]; } };
struct ProbUp {
    static constexpr bool GATHER = true;
    struct Unit { const char* a; const char* b; int e, rt, pn, cnt, prow; };
    const bf16_t* UB; const bf16_t* W;   const float* bup;   const int* TOKL; bf16_t* ACT; MoeTab tab; int G, vcu;
    DI int K() const { return 1024; } DI int lda() const { return 1024; } DI int ldb() const { return 1024; }
    DI bool next(int i, Unit& u) const {
        const int L = i * G + vcu; const int T = L >> 3;
        if (T >= tab.tpre(32)) return false;
        int e = 0;
#pragma unroll 1
        for (int q = 1; q < 32; ++q) e += (T >= tab.tpre(q)) ? 1 : 0;
        e = __builtin_amdgcn_readfirstlane(e);
        const int tp = __builtin_amdgcn_readfirstlane(tab.tpre(e));
        u.e = e; u.rt = T - tp; u.pn = L & 7; u.cnt = __builtin_amdgcn_readfirstlane(tab.cnt(e)); u.prow = (tp + u.rt) * 256;
        u.a = (const char*)UB; u.b = (const char*)(W + ((size_t)e * 2048 + u.pn * 256) * 1024); return true; }
    DI void gather(const Unit& u, int tid, unsigned (&vo)[2][2]) const {
#pragma unroll
        for (int i = 0; i < 2; ++i) { int R, C; g8::stage_rc(tid * 16 + i * 8192, R, C);
#pragma unroll
            for (int h = 0; h < 2; ++h) { const int slot = u.rt * 256 + R + h * 128;
                const int tk = slot < u.cnt ? TOKL[(size_t)u.e * TT + slot] : 0;
                vo[h][i] = (unsigned)(tk >> 2) * 2048u + (unsigned)C * 2u; } }
    }
    DI void epi(const g8::Acc& acc, const Unit& u, int wr, int wc, int fr, int fq) const {
        const int c = u.pn * 128 + wc * 32 + fq * 8;
        const float* bp = bup + (size_t)u.e * 2048 + c;
        const f32x4 bga = *(const f32x4*)bp, bgb = *(const f32x4*)(bp + 4), bla = *(const f32x4*)(bp + 1024), blb = *(const f32x4*)(bp + 1028);
#pragma unroll
        for (int ai = 0; ai < 2; ++ai)
#pragma unroll
            for (int m = 0; m < 4; ++m) {
                const int r = ai * 128 + wr * 64 + m * 16 + fr;
                const f32x4 va = acc[ai][0][m][0] + bga, vb = acc[ai][0][m][1] + bgb, la = acc[ai][1][m][0] + bla, lb = acc[ai][1][m][1] + blb;
                float o[8];
#pragma unroll
                for (int i = 0; i < 4; ++i) {
                    const float g0 = fminf(va[i], 7.0f), l0 = fminf(fmaxf(la[i], -7.0f), 7.0f); o[i] = g0 * sigmoidf_(1.702f * g0) * (l0 + 1.0f);
                    const float g1 = fminf(vb[i], 7.0f), l1 = fminf(fmaxf(lb[i], -7.0f), 7.0f); o[4 + i] = g1 * sigmoidf_(1.702f * g1) * (l1 + 1.0f); }
                u32x4 ov; ov[0] = cvt_pk_bf16(o[0], o[1]); ov[1] = cvt_pk_bf16(o[2], o[3]); ov[2] = cvt_pk_bf16(o[4], o[5]); ov[3] = cvt_pk_bf16(o[6], o[7]);
                *(u32x4*)(ACT + (size_t)(u.prow + r) * D + c) = ov;
            }
    }
};
struct ProbDown {
    static constexpr bool GATHER = false;
    struct Unit { const char* a; const char* b; int e, rt, pn, cnt; };
    const bf16_t* ACT; const bf16_t* W; const float* bdn;   const int* TOKL; const float* GATEL; bf16_t* FEXP; MoeTab tab; int G, vcu;
    DI int K() const { return 1024; } DI int lda() const { return 1024; } DI int ldb() const { return 1024; }
    DI bool next(int i, Unit& u) const {
        const int L = i * G + vcu; const int T = L >> 2;
        if (T >= tab.tpre(32)) return false;
        int e = 0;
#pragma unroll 1
        for (int q = 1; q < 32; ++q) e += (T >= tab.tpre(q)) ? 1 : 0;
        e = __builtin_amdgcn_readfirstlane(e);
        const int tp = __builtin_amdgcn_readfirstlane(tab.tpre(e));
        u.e = e; u.rt = T - tp; u.pn = L & 3; u.cnt = __builtin_amdgcn_readfirstlane(tab.cnt(e));
        u.a = (const char*)(ACT + (size_t)(tp + u.rt) * 256 * D); u.b = (const char*)(W + ((size_t)e * 1024 + u.pn * 256) * 1024); return true; }
    DI void gather(const Unit&, int, unsigned (&)[2][2]) const {}
    DI void epi(const g8::Acc& acc, const Unit& u, int wr, int wc, int fr, int fq) const {
#pragma unroll
        for (int ai = 0; ai < 2; ++ai)
#pragma unroll
            for (int m = 0; m < 4; ++m) {
                const int slot = u.rt * 256 + ai * 128 + wr * 64 + m * 16 + fr;
                if (slot < u.cnt) {
                    const int tk = TOKL[(size_t)u.e * TT + slot]; const float gt = GATEL[(size_t)u.e * TT + slot];
#pragma unroll
                    for (int bj = 0; bj < 2; ++bj) {
                        const int c = u.pn * 256 + bj * 128 + wc * 32 + fq * 8;
                        const float* bp = bdn + (size_t)u.e * 1024 + c;
                        const f32x4 ba = *(const f32x4*)bp, bb = *(const f32x4*)(bp + 4);
                        const f32x4 va = (acc[ai][bj][m][0] + ba) * gt, vb = (acc[ai][bj][m][1] + bb) * gt;
                        u32x4 o; o[0] = cvt_pk_bf16(va[0], va[1]); o[1] = cvt_pk_bf16(va[2], va[3]); o[2] = cvt_pk_bf16(vb[0], vb[1]); o[3] = cvt_pk_bf16(vb[2], vb[3]);
                        *(u32x4*)(FEXP + (size_t)tk * D + c) = o;
                    }
                }
            }
    }
};

enum { IN_INIT = 0, IN_LN = 1, IN_COMBINE = 2 };
enum { OUT_S5 = 0, OUT_CMLR = 1, OUT_ROUTER = 2, OUT_FINAL = 3 };
constexpr int RP_TSTR = 2064;
constexpr int RP_TILE = 0;
constexpr int RP_RED = 66048;
constexpr int RP_LOGIT = RP_RED + 33792;
constexpr int RP_ENT_TK = RP_LOGIT + 4224;
constexpr int RP_ENT_GATE = RP_ENT_TK + 8192;
constexpr int RP_ENT_ER = RP_ENT_GATE + 8192;
constexpr int RP_HIST = RP_ENT_ER + 8192;
constexpr int RP_BASE = RP_HIST + 128;
static_assert(RP_BASE + 128 <= LDS_MISC, "row-pass LDS map");

DI int cm_row(int row) { if (row < TL) { const int l = row & 8191; return (row & ~8191) + (l & 63) * 128 + (l >> 6); } return row; }

template <int INM, int OUTM>
DI void row_pass(const Frame& F, int nrows, int mod_layer_in  , const float* ln_g, const float* ln_b,
                 int mod_layer_out, int mod_sh  , const bf16_t* Wt  , const float* wbias  ,
                 int moe_layer) {
    float* H = (float*)(F.ws + WS_H);
    bf16_t* UB = (bf16_t*)(F.ws + WS_UB);
    bf16_t* UP = (bf16_t*)(F.ws + WS_UP);
    const bf16_t* FEXP = (const bf16_t*)(F.ws + WS_FEXP);
    float* ALR = (float*)(F.ws + WS_ALR);
    LAS unsigned char* lds = F.lds;
    LAS int* hist = (LAS int*)(lds + RP_HIST);
    LAS int* basev = (LAS int*)(lds + RP_BASE);
    LAS int* ent_tk = (LAS int*)(lds + RP_ENT_TK); LAS float* ent_gate = (LAS float*)(lds + RP_ENT_GATE); LAS int* ent_er = (LAS int*)(lds + RP_ENT_ER);
    const int lane = F.lane, w = F.wave, tid = F.tid;
    if (OUTM == OUT_ROUTER) { if (tid < 32) hist[tid] = 0; }
    __syncthreads();
    const int ntiles = nrows / 32;
    int titer = 0;
    for (int tt = F.vcu; tt < ntiles; tt += F.G, ++titer) {
        const int row0 = tt * 32;
        const int b = row0 < TL ? (row0 >> 13) : 4;
        f32x4 lg[4], lb[4], msc[4], msh[4], mg2[4];
#pragma unroll
        for (int i = 0; i < 4; ++i) {
            const int c = 256 * i + 4 * lane;
            if (INM != IN_INIT) { lg[i] = *(const f32x4*)(ln_g + c); lb[i] = *(const f32x4*)(ln_b + c); }
            if (INM == IN_COMBINE) mg2[i] = *(const f32x4*)(modp(F, mod_layer_in, b, 5) + c);
            if (OUTM != OUT_FINAL) { msh[i] = *(const f32x4*)(modp(F, mod_layer_out, b, mod_sh) + c); msc[i] = *(const f32x4*)(modp(F, mod_layer_out, b, mod_sh + 1) + c); }
        }
#pragma unroll 1
        for (int rr = 0; rr < 4; ++rr) {
            const int rl = 4 * w + rr, row = row0 + rl;
            f32x4 v[4];
            if (INM == IN_INIT) {
                const float* src = row < TL ? F.inp(I_X) + (size_t)row * D : F.inp(I_CTX) + (size_t)(row - TL) * D;
#pragma unroll
                for (int i = 0; i < 4; ++i) v[i] = *(const f32x4*)(src + 256 * i + 4 * lane);
            } else {
#pragma unroll
                for (int i = 0; i < 4; ++i) v[i] = *(const f32x4*)(H + (size_t)row * D + 256 * i + 4 * lane);
            }
            if (INM == IN_COMBINE) {
#pragma unroll
                for (int i = 0; i < 4; ++i) {
                    f32x4 f = (f32x4){0.f, 0.f, 0.f, 0.f};
#pragma unroll
                    for (int k = 0; k < 4; ++k) {
                        const u32x2 p = *(const u32x2*)(FEXP + ((size_t)row * 4 + k) * D + 256 * i + 4 * lane);
                        f[0] += bf_lo(p[0]); f[1] += bf_hi(p[0]); f[2] += bf_lo(p[1]); f[3] += bf_hi(p[1]);
                    }
                    v[i] = DN_ALPHA * v[i] + mg2[i] * f;
                }
            }
            if (INM != IN_INIT) {
                float s = 0.f;
#pragma unroll
                for (int i = 0; i < 4; ++i) s += v[i][0] + v[i][1] + v[i][2] + v[i][3];
                const float mean = wave_sum(s) * (1.0f / 1024.0f);
                float q = 0.f;
#pragma unroll
                for (int i = 0; i < 4; ++i) { v[i] = v[i] - mean; q += v[i][0] * v[i][0] + v[i][1] * v[i][1] + v[i][2] * v[i][2] + v[i][3] * v[i][3]; }
                const float rstd = rsqrtf(wave_sum(q) * (1.0f / 1024.0f) + LN_EPS);
#pragma unroll
                for (int i = 0; i < 4; ++i) v[i] = v[i] * rstd * lg[i] + lb[i];
            }
            if (OUTM == OUT_FINAL) {
#pragma unroll
                for (int i = 0; i < 4; ++i) *(f32x4*)(F.out + (size_t)row * D + 256 * i + 4 * lane) = v[i];
            } else {
#pragma unroll
                for (int i = 0; i < 4; ++i) *(f32x4*)(H + (size_t)row * D + 256 * i + 4 * lane) = v[i];
                const int drow = (OUTM == OUT_CMLR) ? cm_row(row) : row;
#pragma unroll
                for (int i = 0; i < 4; ++i) {
                    const f32x4 u = v[i] * (msc[i] + 1.0f) + msh[i];
                    u32x2 p; p[0] = cvt_pk_bf16(u[0], u[1]); p[1] = cvt_pk_bf16(u[2], u[3]);
                    *(LAS u32x2*)(lds + RP_TILE + rl * RP_TSTR + (256 * i + 4 * lane) * 2) = p;
                    if (OUTM != OUT_S5) *(u32x2*)(UB + (size_t)drow * D + 256 * i + 4 * lane) = p;
                }
            }
        }
        if (OUTM == OUT_FINAL) continue;
        __syncthreads();
        if (OUTM == OUT_S5) {
            const int t = lane >> 1, half = lane & 1;
#pragma unroll
            for (int gg = 0; gg < 8; ++gg) {
                const int g = w * 8 + gg;
                const u32x4 p = *(const LAS u32x4*)(lds + RP_TILE + t * RP_TSTR + (g * 16 + half * 8) * 2);
                *(u32x4*)(UP + ((size_t)g * S5ROWS + tt) * 768 + t * 16 + half * 8) = p;
            }
        } else {
            f32x16 acc;
#pragma unroll
            for (int i = 0; i < 16; ++i) acc[i] = 0.f;
            const int r = lane & 31, hh = lane >> 5;
#pragma unroll
            for (int s = 0; s < 8; ++s) {
                const int k0 = 128 * w + 16 * s + 8 * hh;
                const bf16x8 a = *(const LAS bf16x8*)(lds + RP_TILE + r * RP_TSTR + k0 * 2);
                const bf16x8 bb = *(const bf16x8*)(Wt + (size_t)r * D + k0);
                acc = __builtin_amdgcn_mfma_f32_32x32x16_bf16(a, bb, acc, 0, 0, 0);
            }
            LAS float* red = (LAS float*)(lds + RP_RED) + w * (32 * 33);
#pragma unroll
            for (int i = 0; i < 16; ++i) { const int xr = (i & 3) + 8 * (i >> 2) + 4 * hh; red[xr * 33 + r] = acc[i]; }
            __syncthreads();
            LAS float* logit = (LAS float*)(lds + RP_LOGIT);
#pragma unroll
            for (int q = 0; q < 2; ++q) {
                const int idx = tid + 512 * q, xr = idx >> 5, xc = idx & 31;
                float s = wbias ? wbias[xc] : 0.f;
#pragma unroll
                for (int ww = 0; ww < 8; ++ww) s += ((LAS float*)(lds + RP_RED))[ww * (32 * 33) + xr * 33 + xc];
                if (OUTM == OUT_CMLR) ALR[(size_t)cm_row(row0 + xr) * 32 + xc] = s;
                else logit[xr * 33 + xc] = s;
            }
            if (OUTM == OUT_ROUTER) {
                __syncthreads();
                if (tid < 32) {
                    float lv[32];
#pragma unroll
                    for (int e = 0; e < 32; ++e) lv[e] = logit[tid * 33 + e];
                    unsigned taken = 0u; float tv[4]; int ti[4];
#pragma unroll
                    for (int k = 0; k < 4; ++k) {
                        float best = -3.0e38f; int bi = 0;
#pragma unroll
                        for (int e = 0; e < 32; ++e) { const bool ok = !((taken >> e) & 1u) && (lv[e] > best); best = ok ? lv[e] : best; bi = ok ? e : bi; }
                        taken |= 1u << bi; tv[k] = best; ti[k] = bi;
                    }
                    float ex[4], se = 0.f;
#pragma unroll
                    for (int k = 0; k < 4; ++k) { ex[k] = __expf(tv[k] - tv[0]); se += ex[k]; }
                    const float inv = 1.0f / se;
#pragma unroll
                    for (int k = 0; k < 4; ++k) {
                        const int rank = __hip_atomic_fetch_add(&hist[ti[k]], 1, __ATOMIC_RELAXED, __HIP_MEMORY_SCOPE_WORKGROUP);
                        const int n = titer * 128 + tid * 4 + k;
                        ent_tk[n] = (row0 + tid) * 4 + k; ent_gate[n] = ex[k] * inv; ent_er[n] = (ti[k] << 16) | rank;
                    }
                }
            }
        }
        __syncthreads();
    }
    if (OUTM == OUT_ROUTER) {
        __syncthreads();
        unsigned* CNT = (unsigned*)(F.ws + WS_CTL) + CW_CNT + moe_layer * 32;
        if (tid < 32) basev[tid] = (int)__hip_atomic_fetch_add(&CNT[tid], (unsigned)hist[tid], __ATOMIC_RELAXED, __HIP_MEMORY_SCOPE_AGENT);
        __syncthreads();
        int* TOKL = (int*)(F.ws + WS_TOKL); float* GATEL = (float*)(F.ws + WS_GATEL);
        const int nent = titer * 128;
        for (int n = tid; n < nent; n += NTHR) {
            const int er = ent_er[n], e = er >> 16, slot = basev[e] + (er & 0xffff);
            TOKL[(size_t)e * TT + slot] = ent_tk[n]; GATEL[(size_t)e * TT + slot] = ent_gate[n];
        }
    }
}

constexpr int PC_A = 0;
constexpr int PC_BB = 33792;
constexpr int PC_C = PC_BB + 16384;
constexpr int PC_K = PC_C + 16384;
static_assert(PC_K + 65536 <= LDS_MISC, "precompute LDS map");
typedef float cf __attribute__((ext_vector_type(2)));
DI cf mkcf(float x, float y) { cf r; r.x = x; r.y = y; return r; }
DI cf cmul(cf a, cf b) { return mkcf(a.x * b.x - a.y * b.y, a.x * b.y + a.y * b.x); }

DI void s5_precompute(const Frame& F, int j, int g) {
    LAS cf* PA = (LAS cf*)(F.lds + PC_A); LAS cf* PB = (LAS cf*)(F.lds + PC_BB); LAS cf* PCc = (LAS cf*)(F.lds + PC_C); LAS float* PK = (LAS float*)(F.lds + PC_K);
    const int tid = F.tid;
    __syncthreads();
    if (tid < 128) {
        const int dir = tid >> 6, p = tid & 63;
        const size_t gp = ((size_t)(j * 2 + dir) * 64 + g) * 64 + p;
        const float lr = F.inp(I_LAMRE)[gp], li = F.inp(I_LAMIM)[gp];
        const float dt = expf(F.inp(I_LOGSTEP)[(size_t)(j * 2 + dir) * 64 + g]);
        const float mag = expf(lr * dt); float sn, cs; sincosf(li * dt, &sn, &cs);
        const cf a = mkcf(mag * cs, mag * sn);
        const float den = lr * lr + li * li; const float nr = a.x - 1.0f;
        const cf kf = mkcf((nr * lr + a.y * li) / den, (a.y * lr - nr * li) / den);
        cf pw = mkcf(1.0f, 0.0f);
        for (int n = 0; n <= 32; ++n) { PA[(dir * 33 + n) * 64 + p] = pw; pw = cmul(pw, a); }
        for (int h = 0; h < 16; ++h) { const cf bb = mkcf(F.inp(I_BRE)[gp * 16 + h], F.inp(I_BIM)[gp * 16 + h]); PB[(dir * 64 + p) * 16 + h] = cmul(kf, bb); }
        for (int h = 0; h < 16; ++h) { const size_t ci = (((size_t)(j * 2 + dir) * 64 + g) * 16 + h) * 64 + p; PCc[(dir * 16 + h) * 64 + p] = mkcf(F.inp(I_CRE)[ci], F.inp(I_CIM)[ci]); }
    }
    __syncthreads();
    for (int idx = tid; idx < 2 * 32 * 256; idx += NTHR) {
        const int h = idx & 15, hp = (idx >> 4) & 15, tau = (idx >> 8) & 31, dir = idx >> 13;
        float s = 0.f;
        for (int p = 0; p < 64; ++p) { const cf c = PCc[(dir * 16 + hp) * 64 + p], a = PA[(dir * 33 + tau) * 64 + p], bb = PB[(dir * 64 + p) * 16 + h]; const cf ca = cmul(c, a); s += ca.x * bb.x - ca.y * bb.y; }
        PK[idx] = s;
    }
    __syncthreads();
    bf16_t* M = (bf16_t*)(F.ws + WS_S5M) + (size_t)(j * 64 + g) * 512 * 768;
    const float* dsk = F.inp(I_S5D) + (size_t)j * D + g * 16;
    for (int idx = tid; idx < 512 * 768; idx += NTHR) {
        const int rho = idx / 768, kc = idx % 768;
        const int o = (rho & ~31) + perm32(rho & 31);
        const int t = o >> 4, hp = o & 15;
        float val;
        if (kc < 512) {
            const int jj = kc >> 4, h = kc & 15;
            val = 0.f;
            if (jj <= t) val += PK[((0 * 32 + (t - jj)) * 16 + hp) * 16 + h];
            if (jj >= t) val += PK[((1 * 32 + (jj - t)) * 16 + hp) * 16 + h];
            if (jj == t && h == hp) val += dsk[hp];
        } else {
            const int s = kc - 512, dir = s >> 7, im = (s >> 6) & 1, p = s & 63;
            const int n = dir == 0 ? t + 1 : 32 - t;
            const cf z = cmul(PCc[(dir * 16 + hp) * 64 + p], PA[(dir * 33 + n) * 64 + p]);
            val = im ? -z.y : z.x;
        }
        M[idx] = f2bf(val);
    }
    bf16_t* PIN = (bf16_t*)(F.ws + WS_S5PIN) + (size_t)(j * 64 + g) * 256 * 512;
    for (int idx = tid; idx < 256 * 512; idx += NTHR) {
        const int rho = idx >> 9, kc = idx & 511;
        const int s = (rho & ~31) + perm32(rho & 31);
        const int dir = s >> 7, im = (s >> 6) & 1, p = s & 63;
        const int jj = kc >> 4, h = kc & 15;
        const int n = dir == 0 ? 31 - jj : jj;
        const cf x = cmul(PA[(dir * 33 + n) * 64 + p], PB[(dir * 64 + p) * 16 + h]);
        PIN[idx] = f2bf(im ? x.y : x.x);
    }
    if (tid < 128) { const int dir = tid >> 6, p = tid & 63; const cf aT = PA[(dir * 33 + 32) * 64 + p];
        float* AT = (float*)(F.ws + WS_S5AT) + (((size_t)(j * 64 + g) * 2 + dir) * 64 + p) * 2; AT[0] = aT.x; AT[1] = aT.y; }
}

DI void mod_item(const Frame& F, int layer, int nblk) {
    LAS float* cond = (LAS float*)(F.lds);
    LAS float* red = (LAS float*)(F.lds + 20480);
    const int tid = F.tid;
    __syncthreads();
    for (int idx = tid; idx < 5 * 1024; idx += NTHR) { const int r = idx >> 10, k = idx & 1023; const float c = r < 4 ? F.inp(I_C)[r * 1024 + k] : F.inp(I_CCTX)[k]; cond[idx] = c / (1.0f + __expf(-c)); }
    __syncthreads();
    const int cq = tid & 31, kg = tid >> 5, n0 = nblk * 128;
    const float* W = F.inp(I_WADA) + (size_t)layer * 1024 * 6144 + n0 + cq * 4;
    f32x4 acc[5];
#pragma unroll
    for (int r = 0; r < 5; ++r) acc[r] = (f32x4){0.f, 0.f, 0.f, 0.f};
#pragma unroll 8
    for (int kk = 0; kk < 64; ++kk) {
        const int k = kg * 64 + kk;
        const f32x4 wv = *(const f32x4*)(W + (size_t)k * 6144);
#pragma unroll
        for (int r = 0; r < 5; ++r) acc[r] += cond[r * 1024 + k] * wv;
    }
#pragma unroll
    for (int r = 0; r < 5; ++r)
#pragma unroll
        for (int i = 0; i < 4; ++i) red[(kg * 5 + r) * 128 + cq * 4 + i] = acc[r][i];
    __syncthreads();
    for (int idx = tid; idx < 5 * 128; idx += NTHR) {
        const int r = idx >> 7, n = idx & 127;
        float s = F.inp(I_BADA)[(size_t)layer * 6144 + n0 + n];
        for (int q = 0; q < 16; ++q) s += red[(q * 5 + r) * 128 + n];
        ((float*)(F.ws + WS_MOD))[(size_t)(layer * 5 + r) * 6144 + n0 + n] = s;
    }
}

DI int phys_row(int n, int mode) {
    if (mode == 0) return (n & ~31) + inv32(n & 31);
    const int half = n >> 10, jn = n & 1023;
    return 256 * (jn >> 7) + 128 * half + 32 * ((jn & 127) >> 5) + inv32(jn & 31);
}
DI void transpose_tile(const Frame& F, const float* src, int ld, bf16_t* dst, int mode, int kt, int ntile) {
    LAS bf16_t* T = (LAS bf16_t*)F.lds;
    const int tid = F.tid, k0 = kt * 128, n0 = ntile * 128;
    __syncthreads();
#pragma unroll
    for (int q = 0; q < 8; ++q) {
        const int idx = tid + 512 * q, kr = idx >> 5, c4 = idx & 31;
        const f32x4 v = *(const f32x4*)(src + (size_t)(k0 + kr) * ld + n0 + c4 * 4);
#pragma unroll
        for (int i = 0; i < 4; ++i) T[(c4 * 4 + i) * 136 + kr] = f2bf(v[i]);
    }
    __syncthreads();
#pragma unroll
    for (int q = 0; q < 4; ++q) {
        const int idx = tid + 512 * q, nl = idx >> 4, ch = idx & 15;
        const u32x4 p = *(const LAS u32x4*)(T + nl * 136 + ch * 8);
        *(u32x4*)(dst + (size_t)phys_row(n0 + nl, mode) * 1024 + k0 + ch * 8) = p;
    }
}
DI void small_transpose(const Frame& F, const float* src, int ld, int c0, bf16_t* dst) {
    for (int idx = F.tid; idx < 32 * 1024; idx += NTHR) { const int e = idx >> 10, k = idx & 1023; dst[idx] = f2bf(src[(size_t)k * ld + c0 + e]); }
}

constexpr int PI_S5 = 128, PI_MOD = 192, PI_GLU = 2 * 128, PI_WIN = 2 * 192, PI_WOUT = 2 * 64, PI_UP = 128 * 128, PI_DN = 128 * 64, PI_SMALL = 6;
constexpr int PI_TOTAL = PI_S5 + PI_MOD + PI_GLU + PI_WIN + PI_WOUT + PI_UP + PI_DN + PI_SMALL;
DI void prologue_item(const Frame& F, int it) {
    if (it < PI_S5) { s5_precompute(F, it >> 6, it & 63); return; } it -= PI_S5;
    if (it < PI_MOD) { mod_item(F, it / 48, it % 48); return; } it -= PI_MOD;
    if (it < PI_GLU) { const int j = it >> 7, r = it & 127;
        transpose_tile(F, F.inp(I_WGLU) + (size_t)j * 1024 * 2048, 2048, (bf16_t*)(F.ws + WS_WGLU) + (size_t)j * 2048 * 1024, 1, r & 7, r >> 3); return; } it -= PI_GLU;
    if (it < PI_WIN) { const int j = it / 192, r = it % 192;
        transpose_tile(F, F.inp(I_WIN) + (size_t)j * 1024 * 3104, 3104, (bf16_t*)(F.ws + WS_WIN) + (size_t)j * 3072 * 1024, 0, r & 7, r >> 3); return; } it -= PI_WIN;
    if (it < PI_WOUT) { const int j = it >> 6, r = it & 63;
        transpose_tile(F, F.inp(I_WOUT) + (size_t)j * 1024 * 1024, 1024, (bf16_t*)(F.ws + WS_WOUT) + (size_t)j * 1024 * 1024, 0, r & 7, r >> 3); return; } it -= PI_WOUT;
    if (it < PI_UP) { const int le = it >> 7, r = it & 127;
        transpose_tile(F, F.inp(I_WUP) + (size_t)le * 1024 * 2048, 2048, (bf16_t*)(F.ws + WS_WUP) + (size_t)le * 2048 * 1024, 1, r & 7, r >> 3); return; } it -= PI_UP;
    if (it < PI_DN) { const int le = it >> 6, r = it & 63;
        transpose_tile(F, F.inp(I_WDN) + (size_t)le * 1024 * 1024, 1024, (bf16_t*)(F.ws + WS_WDN) + (size_t)le * 1024 * 1024, 0, r & 7, r >> 3); return; } it -= PI_DN;
    if (it < 4) { small_transpose(F, F.inp(I_WROUTER) + (size_t)it * 1024 * 32, 32, 0, (bf16_t*)(F.ws + WS_WR) + (size_t)it * 32 * 1024); return; }
    it -= 4;
    small_transpose(F, F.inp(I_WIN) + (size_t)it * 1024 * 3104, 3104, 3072, (bf16_t*)(F.ws + WS_WLR) + (size_t)it * 32 * 1024);
}

DI void s5_scan(const Frame& F, int j) {
    const float* E = (const float*)(F.ws + WS_E);
    bf16_t* UP = (bf16_t*)(F.ws + WS_UP);
    const float* AT = (const float*)(F.ws + WS_S5AT);
    const int sub = F.tid >> 7, t7 = F.tid & 127, dir = t7 >> 6, p = t7 & 63;
    for (int item = F.vcu + F.G * sub; item < 256; item += 4 * F.G) {
        const int b = item >> 6, g = item & 63;
        const float* at = AT + (((size_t)(j * 64 + g) * 2 + dir) * 64 + p) * 2;
        const float ar = at[0], ai = at[1];
        const float* Eg = E + (size_t)g * S5ROWS * 256 + dir * 128 + p;
        bf16_t* Ug = UP + (size_t)g * S5ROWS * 768 + 512 + dir * 128 + p;
        float sr = 0.f, si = 0.f;
#pragma unroll 1
        for (int blk = 0; blk < 33; ++blk) {
            float er[8], ei[8]; int crs[8];
#pragma unroll
            for (int q = 0; q < 8; ++q) {
                const int s = blk * 8 + q;
                int cr;
                if (s < 8) cr = 1024 + b * 8 + (dir == 0 ? s : 7 - s);
                else cr = b * 256 + (dir == 0 ? (s - 8) : 255 - (s - 8));
                crs[q] = cr;
                er[q] = Eg[(size_t)cr * 256]; ei[q] = Eg[(size_t)cr * 256 + 64];
            }
#pragma unroll
            for (int q = 0; q < 8; ++q) {
                Ug[(size_t)crs[q] * 768] = f2bf(sr); Ug[(size_t)crs[q] * 768 + 64] = f2bf(si);
                const float nr = ar * sr - ai * si + er[q], ni = ar * si + ai * sr + ei[q];
                sr = nr; si = ni;
            }
        }
    }
}

DI bf16_t* qke_ptr(const Frame& F, int dir, int which) { return (bf16_t*)(F.ws + WS_QKE) + (size_t)(dir * 3 + which) * TT * 512; }
DI void gla_gates(const Frame& F, int j) {
    LAS float* as = (LAS float*)F.lds;
    const bf16_t* P = (const bf16_t*)(F.ws + WS_P);
    const float* ALR = (const float*)(F.ws + WS_ALR);
    float* GCH = (float*)(F.ws + WS_GCH);
    const int c = F.tid;
    for (int it = F.vcu; it < 528 * 2; it += F.G) {
        const int cg = it >> 1, dir = it & 1, row0 = cg * 64;
        __syncthreads();
        for (int idx = F.tid; idx < 1024; idx += NTHR) { const int t = idx >> 4, r = idx & 15; as[idx] = ALR[(size_t)(row0 + t) * 32 + dir * 16 + r]; }
        __syncthreads();
        float w[16];
#pragma unroll
        for (int r = 0; r < 16; ++r) w[r] = F.inp(I_WA2)[((size_t)(j * 2 + dir) * 16 + r) * 512 + c];
        const float bias = F.inp(I_BA2)[(size_t)(j * 2 + dir) * 512 + c];
        float tot = 0.f;
#pragma unroll 4
        for (int t = 0; t < 64; ++t) {
            float x = bias;
#pragma unroll
            for (int r4 = 0; r4 < 4; ++r4) { const f32x4 a = *(const LAS f32x4*)(as + t * 16 + r4 * 4); x += a[0] * w[r4 * 4] + a[1] * w[r4 * 4 + 1] + a[2] * w[r4 * 4 + 2] + a[3] * w[r4 * 4 + 3]; }
            const float la = (fminf(x, 0.f) - log1pf(__expf(-fabsf(x)))) * (1.0f / 16.0f);
            tot += la;
        }
        bf16_t* QD = qke_ptr(F, dir, 0); bf16_t* KD = qke_ptr(F, dir, 1); bf16_t* KE = qke_ptr(F, dir, 2);
        float pre = 0.f;
#pragma unroll 4
        for (int t = 0; t < 64; ++t) {
            float x = bias;
#pragma unroll
            for (int r4 = 0; r4 < 4; ++r4) { const f32x4 a = *(const LAS f32x4*)(as + t * 16 + r4 * 4); x += a[0] * w[r4 * 4] + a[1] * w[r4 * 4 + 1] + a[2] * w[r4 * 4 + 2] + a[3] * w[r4 * 4 + 3]; }
            const float la = (fminf(x, 0.f) - log1pf(__expf(-fabsf(x)))) * (1.0f / 16.0f);
            pre += la;
            const float bq = dir == 0 ? pre : (tot - pre + la);
            const float ee = tot - bq;
            const size_t row = (size_t)(row0 + t);
            const float q = bf2f(P[row * 3072 + c]), k = bf2f(P[row * 3072 + 512 + c]);
            QD[row * 512 + c] = f2bf(q * 0.08838834764831845f * __expf(bq));
            KD[row * 512 + c] = f2bf(k * __expf(-bq));
            KE[row * 512 + c] = f2bf(k * __expf(ee));
        }
        GCH[((size_t)cg * 2 + dir) * 512 + c] = __expf(tot);
    }
}

constexpr int GC_XSTR = 272, GC_VSTR = 80, GC_ASTR = 144;
constexpr int GC_QD = 0, GC_KD = 64 * GC_XSTR, GC_KE = 2 * 64 * GC_XSTR, GC_V = 3 * 64 * GC_XSTR, GC_BUF = 3 * 64 * GC_XSTR + 64 * GC_VSTR;
constexpr int GC_ATT = 2 * GC_BUF, GC_S = GC_ATT + 64 * GC_ASTR;
static_assert(GC_S + 128 * GC_VSTR <= LDS_MISC, "gla chunk LDS map");
DI bf16x8 tr_frag(const LAS unsigned char* base, int stride, int k0, int c0, int lane) {
    const int q = (lane & 15) >> 2, p = lane & 3, quad = lane >> 4;
    const LAS unsigned char* a = base + (k0 + quad * 8 + q) * stride + (c0 + 4 * p) * 2;
    const s16x4 lo = __builtin_amdgcn_ds_read_tr16_b64_v4i16((LAS s16x4*)a);
    const s16x4 hi = __builtin_amdgcn_ds_read_tr16_b64_v4i16((LAS s16x4*)(a + 4 * stride));
    return __builtin_shufflevector(lo, hi, 0, 1, 2, 3, 4, 5, 6, 7);
}
DI void gla_chunks(const Frame& F) {
    LAS unsigned char* lds = F.lds;
    const bf16_t* P = (const bf16_t*)(F.ws + WS_P);
    const float* GCH = (const float*)(F.ws + WS_GCH);
    const int tid = F.tid, lane = F.lane, w = F.wave, fr = lane & 15, quad = lane >> 4;
    for (int item = F.vcu; item < 256; item += F.G) {
        const int sl = item & 7, dir = (item >> 3) & 1, hd = (item >> 4) & 3, b = item >> 6;
        const bf16_t* QD = qke_ptr(F, dir, 0); const bf16_t* KD = qke_ptr(F, dir, 1); const bf16_t* KE = qke_ptr(F, dir, 2);
        bf16_t* O = (bf16_t*)(F.ws + WS_O) + (size_t)dir * TT * D;
        __syncthreads();
        for (int idx = tid; idx < 128 * GC_VSTR / 4; idx += NTHR) ((LAS unsigned*)(lds + GC_S))[idx] = 0u;
        f32x4 sacc[2]; sacc[0] = (f32x4){0.f, 0.f, 0.f, 0.f}; sacc[1] = sacc[0];
        u32x4 pq[2], pk[2], pe[2], pv;
        const int xr0 = tid >> 4, xc = tid & 15;
        const int vr = (tid & 255) >> 2, vc = tid & 3;
#define rowbase_of(s) ((s) < 4 ? TL + b * LCTX + (dir == 0 ? (s) : 3 - (s)) * 64 : b * SEQ + (dir == 0 ? ((s) - 4) : 127 - ((s) - 4)) * 64)
#define GC_LOAD(s) do { const int _rb = rowbase_of(s); \
        _Pragma("unroll") for (int _i = 0; _i < 2; ++_i) { const size_t _o = (size_t)(_rb + xr0 + 32 * _i) * 512 + hd * 128 + xc * 8; \
            pq[_i] = *(const u32x4*)(QD + _o); pk[_i] = *(const u32x4*)(KD + _o); pe[_i] = *(const u32x4*)(KE + _o); } \
        if (tid < 256) pv = *(const u32x4*)(P + (size_t)(_rb + vr) * 3072 + 1024 + hd * 256 + sl * 32 + vc * 8); } while (0)
#define GC_STORE(buf) do { LAS unsigned char* _b = lds + (buf) * GC_BUF; \
        _Pragma("unroll") for (int _i = 0; _i < 2; ++_i) { const int _o = (xr0 + 32 * _i) * GC_XSTR + xc * 16; \
            *(LAS u32x4*)(_b + GC_QD + _o) = pq[_i]; *(LAS u32x4*)(_b + GC_KD + _o) = pk[_i]; *(LAS u32x4*)(_b + GC_KE + _o) = pe[_i]; } \
        if (tid < 256) *(LAS u32x4*)(_b + GC_V + vr * GC_VSTR + vc * 16) = pv; } while (0)
        GC_LOAD(0); GC_STORE(0);
        __syncthreads();
#pragma unroll 1
        for (int s = 0; s < 132; ++s) {
            const int cur = s & 1;
            const LAS unsigned char* bq = lds + cur * GC_BUF + GC_QD; const LAS unsigned char* bk = lds + cur * GC_BUF + GC_KD;
            const LAS unsigned char* be = lds + cur * GC_BUF + GC_KE; const LAS unsigned char* bv = lds + cur * GC_BUF + GC_V;
            const int rb = rowbase_of(s);
            if (s + 1 < 132) GC_LOAD(s + 1);
            const f32x4 gv = *(const f32x4*)(GCH + ((size_t)(rb >> 6) * 2 + dir) * 512 + hd * 128 + w * 16 + quad * 4);
#pragma unroll
            for (int q2 = 0; q2 < 2; ++q2) {
                const int id = 2 * w + q2, ti = id >> 2, tj = id & 3;
                f32x4 a4 = (f32x4){0.f, 0.f, 0.f, 0.f};
#pragma unroll
                for (int kk = 0; kk < 4; ++kk) {
                    const bf16x8 af = *(const LAS bf16x8*)(bq + (ti * 16 + fr) * GC_XSTR + (kk * 32 + quad * 8) * 2);
                    const bf16x8 bf = *(const LAS bf16x8*)(bk + (tj * 16 + fr) * GC_XSTR + (kk * 32 + quad * 8) * 2);
                    a4 = __builtin_amdgcn_mfma_f32_16x16x32_bf16(af, bf, a4, 0, 0, 0);
                }
                const int jcol = tj * 16 + fr;
#pragma unroll
                for (int r = 0; r < 4; ++r) { const int irow = ti * 16 + quad * 4 + r; const bool keep = dir == 0 ? (jcol <= irow) : (jcol >= irow);
                    *(LAS bf16_t*)(lds + GC_ATT + irow * GC_ASTR + jcol * 2) = f2bf(keep ? a4[r] : 0.f); }
            }
            const int tm = w >> 1, tn = w & 1;
            f32x4 oacc = (f32x4){0.f, 0.f, 0.f, 0.f};
#pragma unroll
            for (int kk = 0; kk < 4; ++kk) {
                const bf16x8 af = *(const LAS bf16x8*)(bq + (tm * 16 + fr) * GC_XSTR + (kk * 32 + quad * 8) * 2);
                const bf16x8 bf = tr_frag(lds + GC_S, GC_VSTR, kk * 32, tn * 16, lane);
                oacc = __builtin_amdgcn_mfma_f32_16x16x32_bf16(af, bf, oacc, 0, 0, 0);
            }
            __syncthreads();
#pragma unroll
            for (int kk = 0; kk < 2; ++kk) {
                const bf16x8 af = *(const LAS bf16x8*)(lds + GC_ATT + (tm * 16 + fr) * GC_ASTR + (kk * 32 + quad * 8) * 2);
                const bf16x8 bf = tr_frag(bv, GC_VSTR, kk * 32, tn * 16, lane);
                oacc = __builtin_amdgcn_mfma_f32_16x16x32_bf16(af, bf, oacc, 0, 0, 0);
            }
#pragma unroll
            for (int r = 0; r < 4; ++r) O[(size_t)(rb + tm * 16 + quad * 4 + r) * D + hd * 256 + sl * 32 + tn * 16 + fr] = f2bf(oacc[r]);
#pragma unroll
            for (int t2 = 0; t2 < 2; ++t2) {
                f32x4 sa = sacc[t2] * gv;
#pragma unroll
                for (int kk = 0; kk < 2; ++kk) {
                    const bf16x8 af = tr_frag(be, GC_XSTR, kk * 32, w * 16, lane);
                    const bf16x8 bf = tr_frag(bv, GC_VSTR, kk * 32, t2 * 16, lane);
                    sa = __builtin_amdgcn_mfma_f32_16x16x32_bf16(af, bf, sa, 0, 0, 0);
                }
                sacc[t2] = sa;
#pragma unroll
                for (int r = 0; r < 4; ++r) *(LAS bf16_t*)(lds + GC_S + (w * 16 + quad * 4 + r) * GC_VSTR + (t2 * 16 + fr) * 2) = f2bf(sa[r]);
            }
            if (s + 1 < 132) GC_STORE(cur ^ 1);
            __syncthreads();
        }
#undef GC_LOAD
#undef GC_STORE
#undef rowbase_of
    }
}

DI void gla_prep(const Frame& F, int j) {
    const bf16_t* OF = (const bf16_t*)(F.ws + WS_O); const bf16_t* OB = OF + (size_t)TT * D;
    const bf16_t* P = (const bf16_t*)(F.ws + WS_P);
    bf16_t* YG = (bf16_t*)(F.ws + WS_YG);
    const int lane = F.lane;
    const f32x4 ng = *(const f32x4*)(F.inp(I_NORMG) + (size_t)j * 256 + 4 * lane);
    for (int row = F.vcu * 8 + F.wave; row < TT; row += F.G * 8) {
#pragma unroll
        for (int i = 0; i < 4; ++i) {
            const size_t o = (size_t)row * D + 256 * i + 4 * lane;
            const u32x2 a = *(const u32x2*)(OF + o), bb = *(const u32x2*)(OB + o);
            const u32x2 gg = *(const u32x2*)(P + (size_t)row * 3072 + 2048 + 256 * i + 4 * lane);
            f32x4 v; v[0] = bf_lo(a[0]) + bf_lo(bb[0]); v[1] = bf_hi(a[0]) + bf_hi(bb[0]); v[2] = bf_lo(a[1]) + bf_lo(bb[1]); v[3] = bf_hi(a[1]) + bf_hi(bb[1]);
            const float ms = wave_sum(v[0] * v[0] + v[1] * v[1] + v[2] * v[2] + v[3] * v[3]) * (1.0f / 256.0f);
            const float rs = rsqrtf(ms + LN_EPS);
            f32x4 g4; g4[0] = bf_lo(gg[0]); g4[1] = bf_hi(gg[0]); g4[2] = bf_lo(gg[1]); g4[3] = bf_hi(gg[1]);
            f32x4 y;
#pragma unroll
            for (int q = 0; q < 4; ++q) y[q] = v[q] * rs * ng[q] * (g4[q] * sigmoidf_(g4[q]));
            u32x2 p; p[0] = cvt_pk_bf16(y[0], y[1]); p[1] = cvt_pk_bf16(y[2], y[3]);
            *(u32x2*)(YG + o) = p;
        }
    }
}

#ifndef STOP_AT
#define STOP_AT 0
#endif
DI void dump_h(const Frame& F) {
    const f32x4* H = (const f32x4*)(F.ws + WS_H); f32x4* O = (f32x4*)F.out;
    for (size_t i = (size_t)F.vcu * NTHR + F.tid; i < (size_t)TL * D / 4; i += (size_t)F.G * NTHR) O[i] = H[i];
}
#define STOP_CHECK(code) do { if (STOP_AT == (code)) { const Frame L = launder(F); dump_h(L); return; } } while (0)
__global__ void __launch_bounds__(NTHR, 2) fwd_kernel(Args args) {
    extern __shared__ __attribute__((aligned(16))) unsigned char lds_raw[];
    Frame F;
    F.lds = (LAS unsigned char*)lds_raw; F.ws = args.ws; F.in = (inarr_t)__builtin_amdgcn_kernarg_segment_ptr(); F.out = args.out;
    F.tid = threadIdx.x; F.lane = F.tid & 63; F.wave = __builtin_amdgcn_readfirstlane(F.tid >> 6);
    F.G = gridDim.x; { const int bx = blockIdx.x; F.vcu = (F.G % 8 == 0) ? (bx % 8) * (F.G / 8) + bx / 8 : bx; }
    for (int u = F.tid; u < 1024 / 4; u += NTHR) ((LAS unsigned*)(F.lds + LDS_MISC))[u] = 0u;
    __syncthreads();
    F.ws = (unsigned char*)(GBL unsigned char*)(unsigned long long)F.ws; F.out = (float*)(GBL float*)(unsigned long long)F.out;
    XcdBarrier bar = xcd_barrier_post((unsigned*)(F.ws + WS_CTL), (volatile LAS unsigned*)(F.lds + LDS_MISC));
#define GRID_BAR() do { XcdBarrier _b = bar; { unsigned long long _x = (unsigned long long)_b.bar; asm volatile("" : "+s"(_x)); _b.bar = (unsigned*)(GBL unsigned*)_x; } asm volatile("" : "+s"(_b.x)); xcd_barrier(_b); } while (0)
    LAS int* mt = (LAS int*)(F.lds + LDS_MISC + 256);
    volatile LAS int* qslot = (volatile LAS int*)(F.lds + LDS_MISC + 64);

    for (;;) {
        const Frame L = launder(F);
        __syncthreads();
        if (L.tid == 0) *qslot = (int)__hip_atomic_fetch_add((unsigned*)(L.ws + WS_CTL) + CW_QUEUE, 1u, __ATOMIC_RELAXED, __HIP_MEMORY_SCOPE_AGENT);
        __syncthreads();
        const int q = __builtin_amdgcn_readfirstlane(*qslot);
        if (q < PI_S5 + PI_MOD) { prologue_item(L, q); continue; }
        const int base = PI_S5 + PI_MOD + (q - (PI_S5 + PI_MOD)) * 8;
        if (base >= PI_TOTAL) break;
#pragma unroll 1
        for (int it = base; it < base + 8 && it < PI_TOTAL; ++it) prologue_item(L, it);
    }
    GRID_BAR();
    { const Frame L = launder(F); row_pass<IN_INIT, OUT_S5>(L, TT, 0, nullptr, nullptr, 0, 0, nullptr, nullptr, 0); }
    GRID_BAR();
#pragma unroll 1
    for (int layer = 0; layer < DEPTH; ++layer) {
        const int j = layer >> 1;
        if ((layer & 1) == 0) {
            { const Frame L = launder(F); ProbS5E p{(const bf16_t*)(L.ws + WS_UP), (const bf16_t*)(L.ws + WS_S5PIN) + (size_t)j * 64 * 256 * 512, (float*)(L.ws + WS_E), L.G, L.vcu}; g8::gemm_phase(L.lds, L.tid, p); }
            GRID_BAR();
            { const Frame L = launder(F); s5_scan(L, j); }
            GRID_BAR();
            { const Frame L = launder(F); ProbS5Y p{(const bf16_t*)(L.ws + WS_UP), (const bf16_t*)(L.ws + WS_S5M) + (size_t)j * 64 * 512 * 768, (bf16_t*)(L.ws + WS_YG), L.G, L.vcu}; g8::gemm_phase(L.lds, L.tid, p); }
            GRID_BAR();
            { const Frame L = launder(F); ProbGLU p{(const bf16_t*)(L.ws + WS_YG), (const bf16_t*)(L.ws + WS_WGLU) + (size_t)j * 2048 * 1024, (float*)(L.ws + WS_H), (const float*)(L.ws + WS_MOD) + (size_t)layer * 5 * 6144, L.G, L.vcu}; g8::gemm_phase(L.lds, L.tid, p); }
        } else {
            { const Frame L = launder(F); ProbProj p{(const bf16_t*)(L.ws + WS_UB), (const bf16_t*)(L.ws + WS_WIN) + (size_t)j * 3072 * 1024, (bf16_t*)(L.ws + WS_P), L.G, L.vcu}; g8::gemm_phase(L.lds, L.tid, p); }
            GRID_BAR();
            { const Frame L = launder(F); gla_gates(L, j); }
            GRID_BAR();
            { const Frame L = launder(F); gla_chunks(L); }
            GRID_BAR();
            { const Frame L = launder(F); gla_prep(L, j); }
            GRID_BAR();
            { const Frame L = launder(F); ProbOut p{(const bf16_t*)(L.ws + WS_YG), (const bf16_t*)(L.ws + WS_WOUT) + (size_t)j * 1024 * 1024, (float*)(L.ws + WS_H), (const float*)(L.ws + WS_MOD) + (size_t)layer * 5 * 6144, layer == 3 ? TL / 256 : TT / 256, L.G, L.vcu}; g8::gemm_phase(L.lds, L.tid, p); }
        }
        GRID_BAR();
        { const Frame L = launder(F);
          row_pass<IN_LN, OUT_ROUTER>(L, layer == 3 ? TL : TT, layer, L.inp(I_LN1G) + (size_t)layer * D, L.inp(I_LN1B) + (size_t)layer * D, layer, 3,
                                      (const bf16_t*)(L.ws + WS_WR) + (size_t)layer * 32 * 1024, L.inp(I_BROUTER) + (size_t)layer * 32, layer); }
        GRID_BAR();
        if (STOP_AT != 0 && STOP_AT == layer * 2 + 1) { const Frame L = launder(F); dump_h(L); return; }
        { const Frame L = launder(F);
          __syncthreads();
          if (L.tid == 0) { const unsigned* cw = (const unsigned*)(L.ws + WS_CTL) + CW_CNT + layer * 32; int acc = 0; mt[32] = 0; for (int e = 0; e < 32; ++e) { const int c = (int)cw[e]; mt[e] = c; acc += (c + 255) >> 8; mt[33 + e] = acc; } }
          __syncthreads();
          ProbUp p{(const bf16_t*)(L.ws + WS_UB), (const bf16_t*)(L.ws + WS_WUP) + (size_t)layer * 32 * 2048 * 1024, L.inp(I_BUP) + (size_t)layer * 32 * 2048, (const int*)(L.ws + WS_TOKL),
                   (bf16_t*)(L.ws + WS_ACT), MoeTab{mt}, L.G, L.vcu}; g8::gemm_phase(L.lds, L.tid, p); }
        GRID_BAR();
        { const Frame L = launder(F);
          ProbDown p{(const bf16_t*)(L.ws + WS_ACT), (const bf16_t*)(L.ws + WS_WDN) + (size_t)layer * 32 * 1024 * 1024, L.inp(I_BDN) + (size_t)layer * 32 * 1024, (const int*)(L.ws + WS_TOKL),
                     (const float*)(L.ws + WS_GATEL), (bf16_t*)(L.ws + WS_FEXP), MoeTab{mt}, L.G, L.vcu}; g8::gemm_phase(L.lds, L.tid, p); }
        GRID_BAR();
        { const Frame L = launder(F);
          const float* l2g = L.inp(I_LN2G) + (size_t)layer * D; const float* l2b = L.inp(I_LN2B) + (size_t)layer * D;
          if (layer == 3) row_pass<IN_COMBINE, OUT_FINAL>(L, TL, layer, l2g, l2b, 0, 0, nullptr, nullptr, 0);
          else if (layer & 1) row_pass<IN_COMBINE, OUT_S5>(L, TT, layer, l2g, l2b, layer + 1, 0, nullptr, nullptr, 0);
          else row_pass<IN_COMBINE, OUT_CMLR>(L, TT, layer, l2g, l2b, layer + 1, 0, (const bf16_t*)(L.ws + WS_WLR) + (size_t)((layer + 1) >> 1) * 32 * 1024, nullptr, 0); }
        if (layer < 3) GRID_BAR();
        if (STOP_AT != 0 && STOP_AT == layer * 2 + 2) { const Frame L = launder(F); dump_h(L); return; }
    }
}

extern "C" void kernel_launch(void* const* d_in, const int* in_sizes, int n_in, void* d_out, int out_size, void* d_ws, size_t ws_size, hipStream_t stream) {
    static int grid = 0;
    if (grid == 0) {
        if (n_in != 30 || out_size != TL * D || ws_size < WS_END) { fprintf(stderr, "kernel_launch: unexpected shapes (n_in %d out %d ws %zu need %zu)\n", n_in, out_size, ws_size, (size_t)WS_END); grid = -1; return; }
        int dev = 0, cus = 0, per_cu = 0;
        if (hipGetDevice(&dev) != hipSuccess || hipDeviceGetAttribute(&cus, hipDeviceAttributeMultiprocessorCount, dev) != hipSuccess) { grid = -1; return; }
        if (hipFuncSetAttribute((const void*)fwd_kernel, hipFuncAttributeMaxDynamicSharedMemorySize, LDS_BYTES) != hipSuccess) { fprintf(stderr, "kernel_launch: hipFuncSetAttribute failed\n"); grid = -1; return; }
        if (hipOccupancyMaxActiveBlocksPerMultiprocessor(&per_cu, (const void*)fwd_kernel, NTHR, LDS_BYTES) != hipSuccess || per_cu < 1) { fprintf(stderr, "kernel_launch: occupancy query says %d\n", per_cu); }
        (void)hipGetLastError();
        grid = cus;
    }
    if (grid < 0) return;
    (void)in_sizes;
    if (hipMemsetAsync((char*)d_ws + WS_CTL, 0, CTL_BYTES, stream) != hipSuccess) return;
    Args a{};
    for (int i = 0; i < 30; ++i) a.in[i] = (const float*)d_in[i];
    a.out = (float*)d_out; a.ws = (unsigned char*)d_ws;
    hipLaunchKernelGGL(fwd_kernel, dim3(grid), dim3(NTHR), LDS_BYTES, stream, a);
}
```

```cpp
#include <hip/hip_runtime.h>
#include <cstdio>
#include <cstdint>

#define LAS __attribute__((address_space(3)))
#define GBL __attribute__((address_space(1)))
#define DI __device__ __forceinline__
typedef unsigned short bf16_t;
typedef short bf16x8 __attribute__((ext_vector_type(8)));
typedef short s16x4 __attribute__((ext_vector_type(4)));
typedef float f32x4 __attribute__((ext_vector_type(4)));
typedef float f32x16 __attribute__((ext_vector_type(16)));
typedef unsigned u32x4 __attribute__((ext_vector_type(4)));
typedef unsigned u32x2 __attribute__((ext_vector_type(2)));

constexpr int D = 1024, NB = 4, SEQ = 8192, LCTX = 256, DEPTH = 4;
constexpr int TL = NB * SEQ, TC = NB * LCTX, TT = TL + TC;
constexpr int NTHR = 512;
constexpr int S5T = 32;
constexpr int S5ROWS = 1280;
constexpr int S5VALID = 1056;
constexpr int NEXP = 32, TOPK = 4;
constexpr int ACT_ROWS = TT * TOPK + NEXP * 256;
constexpr float DN_ALPHA = 1.6817928305074292f;
constexpr float LN_EPS = 1e-5f;
constexpr int LDS_BYTES = 147456;
constexpr int LDS_MISC = LDS_BYTES - 1024;

constexpr size_t al256(size_t x) { return (x + 255) & ~(size_t)255; }
constexpr size_t CTL_BYTES = 131072;
constexpr size_t WS_CTL   = 0;
constexpr size_t WS_MOD   = WS_CTL + CTL_BYTES;
constexpr size_t WS_H     = al256(WS_MOD + (size_t)DEPTH * 5 * 6144 * 4);
constexpr size_t WS_UB    = al256(WS_H + (size_t)TT * D * 4);
constexpr size_t WS_UP    = al256(WS_UB + (size_t)TT * D * 2);
constexpr size_t WS_E     = al256(WS_UP + (size_t)64 * S5ROWS * 768 * 2);
constexpr size_t WS_YG    = al256(WS_E + (size_t)64 * S5ROWS * 256 * 4);
constexpr size_t WS_P     = al256(WS_YG + (size_t)TT * D * 2);
constexpr size_t WS_ALR   = al256(WS_P + (size_t)TT * 3072 * 2);
constexpr size_t WS_QKE   = al256(WS_ALR + (size_t)TT * 32 * 4);
constexpr size_t WS_GCH   = al256(WS_QKE + (size_t)6 * TT * 512 * 2);
constexpr size_t WS_O     = al256(WS_GCH + (size_t)528 * 2 * 512 * 4);
constexpr size_t WS_TOKL  = al256(WS_O + (size_t)2 * TT * D * 2);
constexpr size_t WS_GATEL = al256(WS_TOKL + (size_t)NEXP * TT * 4);
constexpr size_t WS_ACT   = al256(WS_GATEL + (size_t)NEXP * TT * 4);
constexpr size_t WS_FEXP  = al256(WS_ACT + (size_t)ACT_ROWS * D * 2);
constexpr size_t WS_WGLU  = al256(WS_FEXP + (size_t)TT * 4 * D * 2);
constexpr size_t WS_WIN   = al256(WS_WGLU + (size_t)2 * 2048 * D * 2);
constexpr size_t WS_WOUT  = al256(WS_WIN + (size_t)2 * 3072 * D * 2);
constexpr size_t WS_WUP   = al256(WS_WOUT + (size_t)2 * D * D * 2);
constexpr size_t WS_WDN   = al256(WS_WUP + (size_t)DEPTH * NEXP * 2048 * D * 2);
constexpr size_t WS_WR    = al256(WS_WDN + (size_t)DEPTH * NEXP * D * D * 2);
constexpr size_t WS_WLR   = al256(WS_WR + (size_t)DEPTH * 32 * D * 2);
constexpr size_t WS_S5M   = al256(WS_WLR + (size_t)2 * 32 * D * 2);
constexpr size_t WS_S5PIN = al256(WS_S5M + (size_t)2 * 64 * 512 * 768 * 2);
constexpr size_t WS_S5AT  = al256(WS_S5PIN + (size_t)2 * 64 * 256 * 512 * 2);
constexpr size_t WS_END   = al256(WS_S5AT + (size_t)2 * 64 * 2 * 64 * 2 * 4);

#define CW_QUEUE 3520
#define CW_CNT   3584

#define XB_TMO      128
#define XB_XCNT(j)  (256  + 64 * (j))
#define XB_XSUB(j)  (1280 + 64 * (j))
#define XB_XGEN(j)  (2304 + 64 * (j))
#define XB_TOP      3328
#define XB_TOPGEN   3392
#define XCD_BAR_WORDS 3456
#define XB_SPIN_CAP (1u << 18)

__device__ __forceinline__ unsigned xb_ld(unsigned* p)              { return __hip_atomic_load(p, __ATOMIC_RELAXED, __HIP_MEMORY_SCOPE_AGENT); }
__device__ __forceinline__ unsigned xb_add(unsigned* p, unsigned v) { return __hip_atomic_fetch_add(p, v, __ATOMIC_RELAXED, __HIP_MEMORY_SCOPE_AGENT); }
__device__ __forceinline__ unsigned xb_xcc_id() { return (unsigned)__builtin_amdgcn_s_getreg((3 << 11) | 20) & 0xFu; }
#define XB_SPIN(cond, bar) do { unsigned _sp = 0; while (cond) { __builtin_amdgcn_s_sleep(1); \
    if ((++_sp & 255u) == 0u) { if (xb_ld(&(bar)[XB_TMO])) break; if (_sp > XB_SPIN_CAP) { atomicAdd(&(bar)[XB_TMO], 1u); break; } } } } while (0)

struct XcdBarrier { unsigned* bar; unsigned x; volatile LAS unsigned* st; };

__device__ __forceinline__ XcdBarrier xcd_barrier_post(unsigned* bar, volatile LAS unsigned* st) {
    XcdBarrier b; b.bar = bar; b.x = xb_xcc_id(); b.st = st;
    if (threadIdx.x == 0) (void)xb_add(&bar[XB_XCNT(b.x)], 1u);
    return b;
}
__device__ __forceinline__ void xcd_barrier_complete(unsigned* bar, unsigned x, unsigned& nloc, unsigned& nx) {
    const unsigned G = gridDim.x * gridDim.y * gridDim.z;
    unsigned sum, cnt, mine, sp = 0u;
    for (;;) {
        sum = 0u; cnt = 0u; mine = 0u;
#pragma unroll
        for (unsigned j = 0; j < 16; ++j) { const unsigned c = xb_ld(&bar[XB_XCNT(j)]); sum += c; cnt += (c > 0u) ? 1u : 0u; mine = (j == x) ? c : mine; }
        if (sum == G) break;
        __builtin_amdgcn_s_sleep(1);
        if ((++sp & 255u) == 0u) { if (xb_ld(&bar[XB_TMO])) break; if (sp > XB_SPIN_CAP) { atomicAdd(&bar[XB_TMO], 1u); break; } }
    }
    nloc = mine > 0u ? mine : 1u; nx = cnt > 0u ? cnt : 1u;
}
__device__ __forceinline__ void xcd_barrier(const XcdBarrier& b) {
    asm volatile("s_waitcnt vmcnt(0)" ::: "memory");
    __syncthreads();
    if (threadIdx.x == 0) {
        unsigned* bar = b.bar;
        __builtin_amdgcn_s_waitcnt(0);
        unsigned nloc = b.st[0], nx = b.st[1];
        if (nloc == 0u) { xcd_barrier_complete(bar, b.x, nloc, nx); b.st[0] = nloc; b.st[1] = nx; }
        const unsigned old = xb_add(&bar[XB_XSUB(b.x)], 1u);
        const unsigned gen = old / nloc;
        if (old + 1u == (gen + 1u) * nloc) {
            __builtin_amdgcn_fence(__ATOMIC_RELEASE, "agent");
            asm volatile("s_waitcnt vmcnt(0)" ::: "memory");
            const unsigned og = xb_add(&bar[XB_TOP], 1u);
            const unsigned tg = og / nx;
            if (og + 1u == (tg + 1u) * nx) xb_add(&bar[XB_TOPGEN], 1u);
            else XB_SPIN(xb_ld(&bar[XB_TOPGEN]) == tg, bar);
            __builtin_amdgcn_fence(__ATOMIC_ACQUIRE, "agent");
            xb_add(&bar[XB_XGEN(b.x)], 1u);
            asm volatile("s_waitcnt vmcnt(0)" ::: "memory");
        } else {
            XB_SPIN(xb_ld(&bar[XB_XGEN(b.x)]) == gen, bar);
            __builtin_amdgcn_fence(__ATOMIC_ACQUIRE, "agent");
            asm volatile("s_waitcnt vmcnt(0)" ::: "memory");
        }
    }
    __syncthreads();
}

typedef float f32x2_t __attribute__((ext_vector_type(2)));
typedef __bf16 bf16x2_t __attribute__((ext_vector_type(2)));
DI unsigned cvt_pk_bf16(float lo, float hi) { f32x2_t v; v.x = lo; v.y = hi; return __builtin_bit_cast(unsigned, __builtin_convertvector(v, bf16x2_t)); }
DI float bf_lo(unsigned u) { return __uint_as_float(u << 16); }
DI float bf_hi(unsigned u) { return __uint_as_float(u & 0xffff0000u); }
DI float bf2f(bf16_t b) { return __uint_as_float(((unsigned)b) << 16); }
DI bf16_t f2bf(float f) { return (bf16_t)(cvt_pk_bf16(f, 0.f) & 0xffffu); }
DI float wave_sum(float v) {
#pragma unroll
    for (int m = 32; m >= 1; m >>= 1) v += __shfl_xor(v, m, 64);
    return v;
}
DI float sigmoidf_(float x) { return 1.0f / (1.0f + __expf(-x)); }
DI float gelu_tanh(float x) { const float z = 0.7978845608028654f * (x + 0.044715f * x * x * x); const float t = 1.0f - 2.0f / (__expf(2.0f * z) + 1.0f); return 0.5f * x * (1.0f + t); }
DI int perm32(int rho) { return 8 * ((rho >> 2) & 3) + 4 * (rho >> 4) + (rho & 3); }
DI int inv32(int o) { return 16 * ((o >> 2) & 1) + 4 * (o >> 3) + (o & 3); }

namespace g8 {
constexpr int BM = 256, BK = 64, HALF = 128, HTB = HALF * BK * 2, STAGE_BYTES = 8 * HTB;
DI int lds_byte(int r, int c) { const int st = (r >> 4) * 2 + (c >> 5), rr = r & 15, cc = c & 31, ob = rr * 64 + cc * 2; return st * 1024 + (ob ^ (((ob >> 9) & 1) << 5)); }
DI void stage_rc(int b, int& R, int& C) { const int st = b / 1024, sb = b % 1024, swz = sb ^ (((sb >> 9) & 1) << 5); R = (st >> 1) * 16 + swz / 64; C = (st & 1) * 32 + (swz % 64) / 2; }

typedef f32x4 Acc[2][2][4][2];

template <class P>
DI void gemm_phase(LAS unsigned char* lds, const int tid, P& prob) {
    const int wid = __builtin_amdgcn_readfirstlane(tid >> 6), lane = tid & 63, wr = wid >> 2, wc = wid & 3, fr = lane & 15, fq = lane >> 4;
    const int K = prob.K(), nt = K / BK, lda = prob.lda(), ldb = prob.ldb();
    unsigned cvA[2][2], nvA[2][2], voffB[2];
#pragma unroll
    for (int i = 0; i < 2; ++i) { int R, C; stage_rc(tid * 16 + i * 8192, R, C);
        voffB[i] = (unsigned)(R * ldb + C) * 2u;
        cvA[0][i] = (unsigned)(R * lda + C) * 2u; cvA[1][i] = (unsigned)((R + HALF) * lda + C) * 2u;
        nvA[0][i] = cvA[0][i]; nvA[1][i] = cvA[1][i]; }
    const size_t kstep = (size_t)(BK * 2);
    const size_t hstepB = (size_t)HALF * ldb * 2;
    const unsigned ldsw = (unsigned)wid * 1024u;
    const int aoff = lds_byte(wr * 64 + fr, fq * 8), boff = lds_byte(wc * 32 + fr, fq * 8);
#define G8_SA(b, h) (((b) * 2 + (h)) * HTB)
#define G8_SB(b, h) ((4 + (b) * 2 + (h)) * HTB)
#define G8_STAGE(bufoff, gbase, voff) do { _Pragma("unroll") for (int _i = 0; _i < 2; ++_i) \
        __builtin_amdgcn_global_load_lds((const unsigned*)((const char*)(gbase) + (voff)[_i]), (LAS unsigned*)(lds + (bufoff) + ldsw + _i * 8192), 16, 0, 0); } while (0)
#define G8_STAGE_SEL(bufoff, gbase, h, sel) do { _Pragma("unroll") for (int _i = 0; _i < 2; ++_i) { const unsigned _vo = (P::GATHER && (sel)) ? nvA[h][_i] : cvA[h][_i]; \
        __builtin_amdgcn_global_load_lds((const unsigned*)((const char*)(gbase) + _vo), (LAS unsigned*)(lds + (bufoff) + ldsw + _i * 8192), 16, 0, 0); } } while (0)
#define G8_LDA(dst, b, h) do { _Pragma("unroll") for (int m = 0; m < 4; ++m) _Pragma("unroll") for (int k = 0; k < 2; ++k) dst[m][k] = *(const LAS bf16x8*)(lds + G8_SA(b, h) + aoff + m * 2048 + k * 1024); } while (0)
#define G8_LDB(dst, b, h) do { _Pragma("unroll") for (int n = 0; n < 2; ++n) _Pragma("unroll") for (int k = 0; k < 2; ++k) dst[n][k] = *(const LAS bf16x8*)(lds + G8_SB(b, h) + boff + n * 2048 + k * 1024); } while (0)
#define G8_MMA(ai, bj, At, Bt) do { __builtin_amdgcn_s_setprio(1); _Pragma("unroll") for (int m = 0; m < 4; ++m) _Pragma("unroll") for (int n = 0; n < 2; ++n) _Pragma("unroll") for (int k = 0; k < 2; ++k) \
        acc[ai][bj][m][n] = __builtin_amdgcn_mfma_f32_16x16x32_bf16(Bt[n][k], At[m][k], acc[ai][bj][m][n], 0, 0, 0); __builtin_amdgcn_s_setprio(0); } while (0)
#define G8_WAIT_V(n) asm volatile("s_waitcnt vmcnt(" #n ")" ::: "memory")
#define G8_WAIT_L(n) asm volatile("s_waitcnt lgkmcnt(" #n ")" ::: "memory")
#define G8_BAR __builtin_amdgcn_s_barrier()
#define G8_SCHED __builtin_amdgcn_sched_barrier(0)
    typename P::Unit cur, nxt; int ui = 0;
    if (!prob.next(0, cur)) return;
    Acc acc;
#pragma unroll
    for (int a = 0; a < 2; ++a)
#pragma unroll
        for (int b = 0; b < 2; ++b)
#pragma unroll
            for (int m = 0; m < 4; ++m)
#pragma unroll
                for (int n = 0; n < 2; ++n) acc[a][b][m][n] = (f32x4){0.f, 0.f, 0.f, 0.f};
    bf16x8 At[4][2], B0[2][2], B1[2][2];
    const char* cA = cur.a; const char* cB = cur.b;
    if (P::GATHER) prob.gather(cur, tid, cvA);
    G8_STAGE(G8_SB(0, 0), cB, voffB); G8_STAGE(G8_SA(0, 0), cA, cvA[0]); G8_STAGE(G8_SB(0, 1), cB + hstepB, voffB); G8_STAGE(G8_SA(0, 1), cA, cvA[1]);
    if (wr == 1) G8_BAR;
    G8_WAIT_V(4); G8_BAR;
    G8_STAGE(G8_SB(1, 0), cB + kstep, voffB); G8_STAGE(G8_SA(1, 0), cA + kstep, cvA[0]); G8_STAGE(G8_SB(1, 1), cB + hstepB + kstep, voffB);
    G8_WAIT_V(6); G8_BAR;
    for (;;) {
        const bool has_next = prob.next(ui + 1, nxt);
        const char* nA = has_next ? nxt.a : cA; const char* nB = has_next ? nxt.b : cB;
        if (P::GATHER) { if (has_next) prob.gather(nxt, tid, nvA); else {
#pragma unroll
            for (int h = 0; h < 2; ++h)
#pragma unroll
                for (int i = 0; i < 2; ++i) nvA[h][i] = cvA[h][i]; } }
        for (int t = 0; t < nt; t += 2) {
            const bool last = (t == nt - 2);
            const char* a1 = cA + (size_t)(t + 1) * kstep;
            const char* a2 = last ? nA : cA + (size_t)(t + 2) * kstep; const char* b2 = last ? nB : cB + (size_t)(t + 2) * kstep;
            const char* a3 = a2 + kstep; const char* b3 = b2 + kstep;
            G8_LDB(B0, 0, 0); G8_SCHED; G8_LDA(At, 0, 0); G8_STAGE(G8_SA(1, 1), a1, cvA[1]);
            G8_WAIT_L(8); G8_BAR; G8_WAIT_L(0); G8_MMA(0, 0, At, B0); G8_BAR; G8_SCHED;
            G8_LDB(B1, 0, 1); G8_STAGE(G8_SB(0, 0), b2, voffB);
            G8_BAR; G8_WAIT_L(0); G8_MMA(0, 1, At, B1); G8_BAR;
            G8_LDA(At, 0, 1); G8_STAGE_SEL(G8_SA(0, 0), a2, 0, last);
            G8_BAR; G8_WAIT_L(0); G8_MMA(1, 0, At, B0); G8_BAR; G8_SCHED;
            G8_STAGE(G8_SB(0, 1), b2 + hstepB, voffB);
            G8_WAIT_V(6); G8_BAR; G8_MMA(1, 1, At, B1); G8_BAR;
            G8_LDB(B0, 1, 0); G8_SCHED; G8_LDA(At, 1, 0); G8_STAGE_SEL(G8_SA(0, 1), a2, 1, last);
            G8_WAIT_L(8); G8_BAR; G8_WAIT_L(0); G8_MMA(0, 0, At, B0); G8_BAR; G8_SCHED;
            G8_LDB(B1, 1, 1); G8_STAGE(G8_SB(1, 0), b3, voffB);
            G8_BAR; G8_WAIT_L(0); G8_MMA(0, 1, At, B1); G8_BAR;
            G8_LDA(At, 1, 1); G8_STAGE_SEL(G8_SA(1, 0), a3, 0, last);
            G8_BAR; G8_WAIT_L(0); G8_MMA(1, 0, At, B0); G8_BAR; G8_SCHED;
            G8_STAGE(G8_SB(1, 1), b3 + hstepB, voffB);
            G8_WAIT_V(6); G8_BAR; G8_MMA(1, 1, At, B1); G8_BAR;
        }
        prob.epi(acc, cur, wr, wc, fr, fq);
        if (!has_next) break;
#pragma unroll
        for (int a = 0; a < 2; ++a)
#pragma unroll
            for (int b = 0; b < 2; ++b)
#pragma unroll
                for (int m = 0; m < 4; ++m)
#pragma unroll
                    for (int n = 0; n < 2; ++n) acc[a][b][m][n] = (f32x4){0.f, 0.f, 0.f, 0.f};
        cur = nxt; cA = nA; cB = nB; ++ui;
        if (P::GATHER) {
#pragma unroll
            for (int h = 0; h < 2; ++h)
#pragma unroll
                for (int i = 0; i < 2; ++i) cvA[h][i] = nvA[h][i]; }
    }
    G8_WAIT_V(0);
    if (wr == 0) G8_BAR;
    G8_BAR;
#undef G8_SA
#undef G8_SB
#undef G8_STAGE
#undef G8_STAGE_SEL
#undef G8_LDA
#undef G8_LDB
#undef G8_MMA
#undef G8_WAIT_V
#undef G8_WAIT_L
#undef G8_BAR
#undef G8_SCHED
}
}

struct Args { const float* in[30]; float* out; unsigned char* ws; };
typedef const float* fptr_t;
typedef __attribute__((address_space(4))) const fptr_t* inarr_t;
struct Frame {
    LAS unsigned char* lds; unsigned char* ws; inarr_t in; float* out;
    int tid, lane, wave, G, vcu;
    DI const float* inp(int i) const { return (const float*)(const GBL float*)in[i]; }
};
DI Frame launder(const Frame& F0) {
    Frame F = F0;
    { unsigned long long x = (unsigned long long)F.ws; asm volatile("" : "+s"(x)); F.ws = (unsigned char*)(GBL unsigned char*)x; }
    { unsigned long long x = (unsigned long long)F.out; asm volatile("" : "+s"(x)); F.out = (float*)(GBL float*)x; }
    asm volatile("" : "+s"(F.in));
    asm volatile("" : "+v"(F.tid)); F.lane = F.tid & 63; F.wave = __builtin_amdgcn_readfirstlane(F.tid >> 6);
    asm volatile("" : "+s"(F.G)); asm volatile("" : "+s"(F.vcu));
    return F;
}
enum { I_X = 0, I_C, I_CTX, I_CCTX, I_WADA, I_BADA, I_LN1G, I_LN1B, I_LN2G, I_LN2B, I_LAMRE, I_LAMIM, I_LOGSTEP, I_BRE, I_BIM, I_CRE, I_CIM, I_S5D, I_WGLU,
       I_WIN, I_WA2, I_BA2, I_NORMG, I_WOUT, I_WROUTER, I_BROUTER, I_WUP, I_BUP, I_WDN, I_BDN };

DI const float* modp(const Frame& F, int layer, int b, int which) { return (const float*)(F.ws + WS_MOD) + ((size_t)(layer * 5 + b) * 6 + which) * 1024; }

struct ProbS5E {
    static constexpr bool GATHER = false;
    struct Unit { const char* a; const char* b; int g, rt; };
    const bf16_t* UP; const bf16_t* PIN; float* E; int G, vcu;
    DI int K() const { return 512; } DI int lda() const { return 768; } DI int ldb() const { return 512; }
    DI bool next(int i, Unit& u) const {
        const int L = i * G + vcu; if (L >= 64 * 5) return false;
        u.g = L / 5; u.rt = L % 5;
        u.a = (const char*)(UP + ((size_t)u.g * S5ROWS + u.rt * 256) * 768); u.b = (const char*)(PIN + (size_t)u.g * 256 * 512); return true; }
    DI void gather(const Unit&, int, unsigned (&)[2][2]) const {}
    DI void epi(const g8::Acc& acc, const Unit& u, int wr, int wc, int fr, int fq) const {
#pragma unroll
        for (int ai = 0; ai < 2; ++ai)
#pragma unroll
            for (int m = 0; m < 4; ++m) {
                const int row = u.rt * 256 + ai * 128 + wr * 64 + m * 16 + fr;
                float* rowp = E + ((size_t)u.g * S5ROWS + row) * 256 + wc * 32 + fq * 8;
#pragma unroll
                for (int bj = 0; bj < 2; ++bj) { *(f32x4*)(rowp + bj * 128) = acc[ai][bj][m][0]; *(f32x4*)(rowp + bj * 128 + 4) = acc[ai][bj][m][1]; }
            }
    }
};
struct ProbS5Y {
    static constexpr bool GATHER = false;
    struct Unit { const char* a; const char* b; int g, rt, pn; };
    const bf16_t* UP; const bf16_t* M; bf16_t* YG; int G, vcu;
    DI int K() const { return 768; } DI int lda() const { return 768; } DI int ldb() const { return 768; }
    DI bool next(int i, Unit& u) const {
        const int L = i * G + vcu; if (L >= 64 * 5 * 2) return false;
        u.pn = L & 1; u.rt = (L >> 1) % 5; u.g = L / 10;
        u.a = (const char*)(UP + ((size_t)u.g * S5ROWS + u.rt * 256) * 768); u.b = (const char*)(M + ((size_t)u.g * 512 + u.pn * 256) * 768); return true; }
    DI void gather(const Unit&, int, unsigned (&)[2][2]) const {}
    DI void epi(const g8::Acc& acc, const Unit& u, int wr, int wc, int fr, int fq) const {
#pragma unroll
        for (int ai = 0; ai < 2; ++ai)
#pragma unroll
            for (int m = 0; m < 4; ++m) {
                const int cr = u.rt * 256 + ai * 128 + wr * 64 + m * 16 + fr;
                if (cr < S5VALID) {
                    const int tokbase = cr < 1024 ? (cr >> 8) * SEQ + (cr & 255) * S5T : TL + (cr - 1024) * S5T;
#pragma unroll
                    for (int bj = 0; bj < 2; ++bj) {
                        const int c = u.pn * 256 + bj * 128 + wc * 32 + fq * 8;
                        const int t = c >> 4, h0 = c & 15;
                        const f32x4 v0 = acc[ai][bj][m][0], v1 = acc[ai][bj][m][1];
                        u32x4 o; o[0] = cvt_pk_bf16(gelu_tanh(v0[0]), gelu_tanh(v0[1])); o[1] = cvt_pk_bf16(gelu_tanh(v0[2]), gelu_tanh(v0[3]));
                        o[2] = cvt_pk_bf16(gelu_tanh(v1[0]), gelu_tanh(v1[1])); o[3] = cvt_pk_bf16(gelu_tanh(v1[2]), gelu_tanh(v1[3]));
                        *(u32x4*)(YG + (size_t)(tokbase + t) * D + u.g * 16 + h0) = o;
                    }
                }
            }
    }
};
struct ProbGLU {
    static constexpr bool GATHER = false;
    struct Unit { const char* a; const char* b; int rt, pn; };
    const bf16_t* A; const bf16_t* W; float* H; const float* mod_g1_base;   int G, vcu;
    DI int K() const { return 1024; } DI int lda() const { return 1024; } DI int ldb() const { return 1024; }
    DI bool next(int i, Unit& u) const {
        const int L = i * G + vcu; if (L >= (TT / 256) * 8) return false;
        u.pn = L & 7; u.rt = L >> 3;
        u.a = (const char*)(A + (size_t)u.rt * 256 * 1024); u.b = (const char*)(W + (size_t)u.pn * 256 * 1024); return true; }
    DI void gather(const Unit&, int, unsigned (&)[2][2]) const {}
    DI void epi(const g8::Acc& acc, const Unit& u, int wr, int wc, int fr, int fq) const {
        const int row0 = u.rt * 256; const int b = row0 < TL ? (row0 >> 13) : 4;
        const int c = u.pn * 128 + wc * 32 + fq * 8;
        const float* g1p = mod_g1_base + (size_t)b * 6144 + 2 * 1024 + c;
        const f32x4 g1a = *(const f32x4*)g1p, g1b = *(const f32x4*)(g1p + 4);
#pragma unroll
        for (int ai = 0; ai < 2; ++ai)
#pragma unroll
            for (int m = 0; m < 4; ++m) {
                const int row = row0 + ai * 128 + wr * 64 + m * 16 + fr;
                float* hp = H + (size_t)row * D + c;
                f32x4 h0 = *(f32x4*)hp, h1 = *(f32x4*)(hp + 4);
                const f32x4 va = acc[ai][0][m][0], vb = acc[ai][0][m][1], ga = acc[ai][1][m][0], gb = acc[ai][1][m][1];
#pragma unroll
                for (int i = 0; i < 4; ++i) { h0[i] = DN_ALPHA * h0[i] + g1a[i] * (va[i] * sigmoidf_(ga[i])); h1[i] = DN_ALPHA * h1[i] + g1b[i] * (vb[i] * sigmoidf_(gb[i])); }
                *(f32x4*)hp = h0; *(f32x4*)(hp + 4) = h1;
            }
    }
};
struct ProbProj {
    static constexpr bool GATHER = false;
    struct Unit { const char* a; const char* b; int rt, pn; };
    const bf16_t* A; const bf16_t* W; bf16_t* P; int G, vcu;
    DI int K() const { return 1024; } DI int lda() const { return 1024; } DI int ldb() const { return 1024; }
    DI bool next(int i, Unit& u) const {
        const int L = i * G + vcu; if (L >= (TT / 256) * 12) return false;
        u.pn = L % 12; u.rt = L / 12;
        u.a = (const char*)(A + (size_t)u.rt * 256 * 1024); u.b = (const char*)(W + (size_t)u.pn * 256 * 1024); return true; }
    DI void gather(const Unit&, int, unsigned (&)[2][2]) const {}
    DI void epi(const g8::Acc& acc, const Unit& u, int wr, int wc, int fr, int fq) const {
#pragma unroll
        for (int ai = 0; ai < 2; ++ai)
#pragma unroll
            for (int m = 0; m < 4; ++m) {
                const int row = u.rt * 256 + ai * 128 + wr * 64 + m * 16 + fr;
#pragma unroll
                for (int bj = 0; bj < 2; ++bj) {
                    const int c = u.pn * 256 + bj * 128 + wc * 32 + fq * 8;
                    const f32x4 v0 = acc[ai][bj][m][0], v1 = acc[ai][bj][m][1];
                    u32x4 o; o[0] = cvt_pk_bf16(v0[0], v0[1]); o[1] = cvt_pk_bf16(v0[2], v0[3]); o[2] = cvt_pk_bf16(v1[0], v1[1]); o[3] = cvt_pk_bf16(v1[2], v1[3]);
                    *(u32x4*)(P + (size_t)row * 3072 + c) = o;
                }
            }
    }
};
struct ProbOut {
    static constexpr bool GATHER = false;
    struct Unit { const char* a; const char* b; int rt, pn; };
    const bf16_t* A; const bf16_t* W; float* H; const float* mod_g1_base; int nrt; int G, vcu;
    DI int K() const { return 1024; } DI int lda() const { return 1024; } DI int ldb() const { return 1024; }
    DI bool next(int i, Unit& u) const {
        const int L = i * G + vcu; if (L >= nrt * 4) return false;
        u.pn = L & 3; u.rt = L >> 2;
        u.a = (const char*)(A + (size_t)u.rt * 256 * 1024); u.b = (const char*)(W + (size_t)u.pn * 256 * 1024); return true; }
    DI void gather(const Unit&, int, unsigned (&)[2][2]) const {}
    DI void epi(const g8::Acc& acc, const Unit& u, int wr, int wc, int fr, int fq) const {
        const int row0 = u.rt * 256; const int b = row0 < TL ? (row0 >> 13) : 4;
#pragma unroll
        for (int ai = 0; ai < 2; ++ai)
#pragma unroll
            for (int m = 0; m < 4; ++m) {
                const int r = row0 + ai * 128 + wr * 64 + m * 16 + fr;
                int tok = r;
                if (r < TL) { const int np = r & 8191; tok = (r & ~8191) + (np & 127) * 64 + (np >> 7); }
#pragma unroll
                for (int bj = 0; bj < 2; ++bj) {
                    const int c = u.pn * 256 + bj * 128 + wc * 32 + fq * 8;
                    const float* g1p = mod_g1_base + (size_t)b * 6144 + 2 * 1024 + c;
                    const f32x4 g1a = *(const f32x4*)g1p, g1b = *(const f32x4*)(g1p + 4);
                    float* hp = H + (size_t)tok * D + c;
                    f32x4 h0 = *(f32x4*)hp, h1 = *(f32x4*)(hp + 4);
                    const f32x4 va = acc[ai][bj][m][0], vb = acc[ai][bj][m][1];
#pragma unroll
                    for (int i = 0; i < 4; ++i) { h0[i] = DN_ALPHA * h0[i] + g1a[i] * va[i]; h1[i] = DN_ALPHA * h1[i] + g1b[i] * vb[i]; }
                    *(f32x4*)hp = h0; *(f32x4*)(hp + 4) = h1;
                }
            }
    }
};
struct MoeTab { const LAS int* t; DI int cnt(int e) const { return t[e]; } DI int tpre(int e) const { return t[32 + e]; } };
struct ProbUp {
    static constexpr bool GATHER = true;
    struct Unit { const char* a; const char* b; int e, rt, pn, cnt, prow; };
    const bf16_t* UB; const bf16_t* W;   const float* bup;   const int* TOKL; bf16_t* ACT; MoeTab tab; int G, vcu;
    DI int K() const { return 1024; } DI int lda() const { return 1024; } DI int ldb() const { return 1024; }
    DI bool next(int i, Unit& u) const {
        const int L = i * G + vcu; const int T = L >> 3;
        if (T >= tab.tpre(32)) return false;
        int e = 0;
#pragma unroll 1
        for (int q = 1; q < 32; ++q) e += (T >= tab.tpre(q)) ? 1 : 0;
        e = __builtin_amdgcn_readfirstlane(e);
        const int tp = __builtin_amdgcn_readfirstlane(tab.tpre(e));
        u.e = e; u.rt = T - tp; u.pn = L & 7; u.cnt = __builtin_amdgcn_readfirstlane(tab.cnt(e)); u.prow = (tp + u.rt) * 256;
        u.a = (const char*)UB; u.b = (const char*)(W + ((size_t)e * 2048 + u.pn * 256) * 1024); return true; }
    DI void gather(const Unit& u, int tid, unsigned (&vo)[2][2]) const {
#pragma unroll
        for (int i = 0; i < 2; ++i) { int R, C; g8::stage_rc(tid * 16 + i * 8192, R, C);
#pragma unroll
            for (int h = 0; h < 2; ++h) { const int slot = u.rt * 256 + R + h * 128;
                const int tk = slot < u.cnt ? TOKL[(size_t)u.e * TT + slot] : 0;
                vo[h][i] = (unsigned)(tk >> 2) * 2048u + (unsigned)C * 2u; } }
    }
    DI void epi(const g8::Acc& acc, const Unit& u, int wr, int wc, int fr, int fq) const {
        const int c = u.pn * 128 + wc * 32 + fq * 8;
        const float* bp = bup + (size_t)u.e * 2048 + c;
        const f32x4 bga = *(const f32x4*)bp, bgb = *(const f32x4*)(bp + 4), bla = *(const f32x4*)(bp + 1024), blb = *(const f32x4*)(bp + 1028);
#pragma unroll
        for (int ai = 0; ai < 2; ++ai)
#pragma unroll
            for (int m = 0; m < 4; ++m) {
                const int r = ai * 128 + wr * 64 + m * 16 + fr;
                const f32x4 va = acc[ai][0][m][0] + bga, vb = acc[ai][0][m][1] + bgb, la = acc[ai][1][m][0] + bla, lb = acc[ai][1][m][1] + blb;
                float o[8];
#pragma unroll
                for (int i = 0; i < 4; ++i) {
                    const float g0 = fminf(va[i], 7.0f), l0 = fminf(fmaxf(la[i], -7.0f), 7.0f); o[i] = g0 * sigmoidf_(1.702f * g0) * (l0 + 1.0f);
                    const float g1 = fminf(vb[i], 7.0f), l1 = fminf(fmaxf(lb[i], -7.0f), 7.0f); o[4 + i] = g1 * sigmoidf_(1.702f * g1) * (l1 + 1.0f); }
                u32x4 ov; ov[0] = cvt_pk_bf16(o[0], o[1]); ov[1] = cvt_pk_bf16(o[2], o[3]); ov[2] = cvt_pk_bf16(o[4], o[5]); ov[3] = cvt_pk_bf16(o[6], o[7]);
                *(u32x4*)(ACT + (size_t)(u.prow + r) * D + c) = ov;
            }
    }
};
struct ProbDown {
    static constexpr bool GATHER = false;
    struct Unit { const char* a; const char* b; int e, rt, pn, cnt; };
    const bf16_t* ACT; const bf16_t* W; const float* bdn;   const int* TOKL; const float* GATEL; bf16_t* FEXP; MoeTab tab; int G, vcu;
    DI int K() const { return 1024; } DI int lda() const { return 1024; } DI int ldb() const { return 1024; }
    DI bool next(int i, Unit& u) const {
        const int L = i * G + vcu; const int T = L >> 2;
        if (T >= tab.tpre(32)) return false;
        int e = 0;
#pragma unroll 1
        for (int q = 1; q < 32; ++q) e += (T >= tab.tpre(q)) ? 1 : 0;
        e = __builtin_amdgcn_readfirstlane(e);
        const int tp = __builtin_amdgcn_readfirstlane(tab.tpre(e));
        u.e = e; u.rt = T - tp; u.pn = L & 3; u.cnt = __builtin_amdgcn_readfirstlane(tab.cnt(e));
        u.a = (const char*)(ACT + (size_t)(tp + u.rt) * 256 * D); u.b = (const char*)(W + ((size_t)e * 1024 + u.pn * 256) * 1024); return true; }
    DI void gather(const Unit&, int, unsigned (&)[2][2]) const {}
    DI void epi(const g8::Acc& acc, const Unit& u, int wr, int wc, int fr, int fq) const {
#pragma unroll
        for (int ai = 0; ai < 2; ++ai)
#pragma unroll
            for (int m = 0; m < 4; ++m) {
                const int slot = u.rt * 256 + ai * 128 + wr * 64 + m * 16 + fr;
                if (slot < u.cnt) {
                    const int tk = TOKL[(size_t)u.e * TT + slot]; const float gt = GATEL[(size_t)u.e * TT + slot];
#pragma unroll
                    for (int bj = 0; bj < 2; ++bj) {
                        const int c = u.pn * 256 + bj * 128 + wc * 32 + fq * 8;
                        const float* bp = bdn + (size_t)u.e * 1024 + c;
                        const f32x4 ba = *(const f32x4*)bp, bb = *(const f32x4*)(bp + 4);
                        const f32x4 va = (acc[ai][bj][m][0] + ba) * gt, vb = (acc[ai][bj][m][1] + bb) * gt;
                        u32x4 o; o[0] = cvt_pk_bf16(va[0], va[1]); o[1] = cvt_pk_bf16(va[2], va[3]); o[2] = cvt_pk_bf16(vb[0], vb[1]); o[3] = cvt_pk_bf16(vb[2], vb[3]);
                        *(u32x4*)(FEXP + (size_t)tk * D + c) = o;
                    }
                }
            }
    }
};

enum { IN_INIT = 0, IN_LN = 1, IN_COMBINE = 2 };
enum { OUT_S5 = 0, OUT_CMLR = 1, OUT_ROUTER = 2, OUT_FINAL = 3 };
constexpr int RP_TSTR = 2064;
constexpr int RP_TILE = 0;
constexpr int RP_RED = 66048;
constexpr int RP_LOGIT = RP_RED + 33792;
constexpr int RP_ENT_TK = RP_LOGIT + 4224;
constexpr int RP_ENT_GATE = RP_ENT_TK + 8192;
constexpr int RP_ENT_ER = RP_ENT_GATE + 8192;
constexpr int RP_HIST = RP_ENT_ER + 8192;
constexpr int RP_BASE = RP_HIST + 128;
static_assert(RP_BASE + 128 <= LDS_MISC, "row-pass LDS map");

DI int cm_row(int row) { if (row < TL) { const int l = row & 8191; return (row & ~8191) + (l & 63) * 128 + (l >> 6); } return row; }

template <int INM, int OUTM>
DI void row_pass(const Frame& F, int nrows, int mod_layer_in  , const float* ln_g, const float* ln_b,
                 int mod_layer_out, int mod_sh  , const bf16_t* Wt  , const float* wbias  ,
                 int moe_layer) {
    float* H = (float*)(F.ws + WS_H);
    bf16_t* UB = (bf16_t*)(F.ws + WS_UB);
    bf16_t* UP = (bf16_t*)(F.ws + WS_UP);
    const bf16_t* FEXP = (const bf16_t*)(F.ws + WS_FEXP);
    float* ALR = (float*)(F.ws + WS_ALR);
    LAS unsigned char* lds = F.lds;
    LAS int* hist = (LAS int*)(lds + RP_HIST);
    LAS int* basev = (LAS int*)(lds + RP_BASE);
    LAS int* ent_tk = (LAS int*)(lds + RP_ENT_TK); LAS float* ent_gate = (LAS float*)(lds + RP_ENT_GATE); LAS int* ent_er = (LAS int*)(lds + RP_ENT_ER);
    const int lane = F.lane, w = F.wave, tid = F.tid;
    if (OUTM == OUT_ROUTER) { if (tid < 32) hist[tid] = 0; }
    __syncthreads();
    const int ntiles = nrows / 32;
    int titer = 0;
    for (int tt = F.vcu; tt < ntiles; tt += F.G, ++titer) {
        const int row0 = tt * 32;
        const int b = row0 < TL ? (row0 >> 13) : 4;
        f32x4 lg[4], lb[4], msc[4], msh[4], mg2[4];
#pragma unroll
        for (int i = 0; i < 4; ++i) {
            const int c = 256 * i + 4 * lane;
            if (INM != IN_INIT) { lg[i] = *(const f32x4*)(ln_g + c); lb[i] = *(const f32x4*)(ln_b + c); }
            if (INM == IN_COMBINE) mg2[i] = *(const f32x4*)(modp(F, mod_layer_in, b, 5) + c);
            if (OUTM != OUT_FINAL) { msh[i] = *(const f32x4*)(modp(F, mod_layer_out, b, mod_sh) + c); msc[i] = *(const f32x4*)(modp(F, mod_layer_out, b, mod_sh + 1) + c); }
        }
#pragma unroll 1
        for (int rr = 0; rr < 4; ++rr) {
            const int rl = 4 * w + rr, row = row0 + rl;
            f32x4 v[4];
            if (INM == IN_INIT) {
                const float* src = row < TL ? F.inp(I_X) + (size_t)row * D : F.inp(I_CTX) + (size_t)(row - TL) * D;
#pragma unroll
                for (int i = 0; i < 4; ++i) v[i] = *(const f32x4*)(src + 256 * i + 4 * lane);
            } else {
#pragma unroll
                for (int i = 0; i < 4; ++i) v[i] = *(const f32x4*)(H + (size_t)row * D + 256 * i + 4 * lane);
            }
            if (INM == IN_COMBINE) {
#pragma unroll
                for (int i = 0; i < 4; ++i) {
                    f32x4 f = (f32x4){0.f, 0.f, 0.f, 0.f};
#pragma unroll
                    for (int k = 0; k < 4; ++k) {
                        const u32x2 p = *(const u32x2*)(FEXP + ((size_t)row * 4 + k) * D + 256 * i + 4 * lane);
                        f[0] += bf_lo(p[0]); f[1] += bf_hi(p[0]); f[2] += bf_lo(p[1]); f[3] += bf_hi(p[1]);
                    }
                    v[i] = DN_ALPHA * v[i] + mg2[i] * f;
                }
            }
            if (INM != IN_INIT) {
                float s = 0.f;
#pragma unroll
                for (int i = 0; i < 4; ++i) s += v[i][0] + v[i][1] + v[i][2] + v[i][3];
                const float mean = wave_sum(s) * (1.0f / 1024.0f);
                float q = 0.f;
#pragma unroll
                for (int i = 0; i < 4; ++i) { v[i] = v[i] - mean; q += v[i][0] * v[i][0] + v[i][1] * v[i][1] + v[i][2] * v[i][2] + v[i][3] * v[i][3]; }
                const float rstd = rsqrtf(wave_sum(q) * (1.0f / 1024.0f) + LN_EPS);
#pragma unroll
                for (int i = 0; i < 4; ++i) v[i] = v[i] * rstd * lg[i] + lb[i];
            }
            if (OUTM == OUT_FINAL) {
#pragma unroll
                for (int i = 0; i < 4; ++i) *(f32x4*)(F.out + (size_t)row * D + 256 * i + 4 * lane) = v[i];
            } else {
#pragma unroll
                for (int i = 0; i < 4; ++i) *(f32x4*)(H + (size_t)row * D + 256 * i + 4 * lane) = v[i];
                const int drow = (OUTM == OUT_CMLR) ? cm_row(row) : row;
#pragma unroll
                for (int i = 0; i < 4; ++i) {
                    const f32x4 u = v[i] * (msc[i] + 1.0f) + msh[i];
                    u32x2 p; p[0] = cvt_pk_bf16(u[0], u[1]); p[1] = cvt_pk_bf16(u[2], u[3]);
                    *(LAS u32x2*)(lds + RP_TILE + rl * RP_TSTR + (256 * i + 4 * lane) * 2) = p;
                    if (OUTM != OUT_S5) *(u32x2*)(UB + (size_t)drow * D + 256 * i + 4 * lane) = p;
                }
            }
        }
        if (OUTM == OUT_FINAL) continue;
        __syncthreads();
        if (OUTM == OUT_S5) {
            const int t = lane >> 1, half = lane & 1;
#pragma unroll
            for (int gg = 0; gg < 8; ++gg) {
                const int g = w * 8 + gg;
                const u32x4 p = *(const LAS u32x4*)(lds + RP_TILE + t * RP_TSTR + (g * 16 + half * 8) * 2);
                *(u32x4*)(UP + ((size_t)g * S5ROWS + tt) * 768 + t * 16 + half * 8) = p;
            }
        } else {
            f32x16 acc;
#pragma unroll
            for (int i = 0; i < 16; ++i) acc[i] = 0.f;
            const int r = lane & 31, hh = lane >> 5;
#pragma unroll
            for (int s = 0; s < 8; ++s) {
                const int k0 = 128 * w + 16 * s + 8 * hh;
                const bf16x8 a = *(const LAS bf16x8*)(lds + RP_TILE + r * RP_TSTR + k0 * 2);
                const bf16x8 bb = *(const bf16x8*)(Wt + (size_t)r * D + k0);
                acc = __builtin_amdgcn_mfma_f32_32x32x16_bf16(a, bb, acc, 0, 0, 0);
            }
            LAS float* red = (LAS float*)(lds + RP_RED) + w * (32 * 33);
#pragma unroll
            for (int i = 0; i < 16; ++i) { const int xr = (i & 3) + 8 * (i >> 2) + 4 * hh; red[xr * 33 + r] = acc[i]; }
            __syncthreads();
            LAS float* logit = (LAS float*)(lds + RP_LOGIT);
#pragma unroll
            for (int q = 0; q < 2; ++q) {
                const int idx = tid + 512 * q, xr = idx >> 5, xc = idx & 31;
                float s = wbias ? wbias[xc] : 0.f;
#pragma unroll
                for (int ww = 0; ww < 8; ++ww) s += ((LAS float*)(lds + RP_RED))[ww * (32 * 33) + xr * 33 + xc];
                if (OUTM == OUT_CMLR) ALR[(size_t)cm_row(row0 + xr) * 32 + xc] = s;
                else logit[xr * 33 + xc] = s;
            }
            if (OUTM == OUT_ROUTER) {
                __syncthreads();
                if (tid < 32) {
                    float lv[32];
#pragma unroll
                    for (int e = 0; e < 32; ++e) lv[e] = logit[tid * 33 + e];
                    unsigned taken = 0u; float tv[4]; int ti[4];
#pragma unroll
                    for (int k = 0; k < 4; ++k) {
                        float best = -3.0e38f; int bi = 0;
#pragma unroll
                        for (int e = 0; e < 32; ++e) { const bool ok = !((taken >> e) & 1u) && (lv[e] > best); best = ok ? lv[e] : best; bi = ok ? e : bi; }
                        taken |= 1u << bi; tv[k] = best; ti[k] = bi;
                    }
                    float ex[4], se = 0.f;
#pragma unroll
                    for (int k = 0; k < 4; ++k) { ex[k] = __expf(tv[k] - tv[0]); se += ex[k]; }
                    const float inv = 1.0f / se;
#pragma unroll
                    for (int k = 0; k < 4; ++k) {
                        const int rank = __hip_atomic_fetch_add(&hist[ti[k]], 1, __ATOMIC_RELAXED, __HIP_MEMORY_SCOPE_WORKGROUP);
                        const int n = titer * 128 + tid * 4 + k;
                        ent_tk[n] = (row0 + tid) * 4 + k; ent_gate[n] = ex[k] * inv; ent_er[n] = (ti[k] << 16) | rank;
                    }
                }
            }
        }
        __syncthreads();
    }
    if (OUTM == OUT_ROUTER) {
        __syncthreads();
        unsigned* CNT = (unsigned*)(F.ws + WS_CTL) + CW_CNT + moe_layer * 32;
        if (tid < 32) basev[tid] = (int)__hip_atomic_fetch_add(&CNT[tid], (unsigned)hist[tid], __ATOMIC_RELAXED, __HIP_MEMORY_SCOPE_AGENT);
        __syncthreads();
        int* TOKL = (int*)(F.ws + WS_TOKL); float* GATEL = (float*)(F.ws + WS_GATEL);
        const int nent = titer * 128;
        for (int n = tid; n < nent; n += NTHR) {
            const int er = ent_er[n], e = er >> 16, slot = basev[e] + (er & 0xffff);
            TOKL[(size_t)e * TT + slot] = ent_tk[n]; GATEL[(size_t)e * TT + slot] = ent_gate[n];
        }
    }
}

constexpr int PC_A = 0;
constexpr int PC_BB = 33792;
constexpr int PC_C = PC_BB + 16384;
constexpr int PC_K = PC_C + 16384;
static_assert(PC_K + 65536 <= LDS_MISC, "precompute LDS map");
typedef float cf __attribute__((ext_vector_type(2)));
DI cf mkcf(float x, float y) { cf r; r.x = x; r.y = y; return r; }
DI cf cmul(cf a, cf b) { return mkcf(a.x * b.x - a.y * b.y, a.x * b.y + a.y * b.x); }

DI void s5_precompute(const Frame& F, int j, int g) {
    LAS cf* PA = (LAS cf*)(F.lds + PC_A); LAS cf* PB = (LAS cf*)(F.lds + PC_BB); LAS cf* PCc = (LAS cf*)(F.lds + PC_C); LAS float* PK = (LAS float*)(F.lds + PC_K);
    const int tid = F.tid;
    __syncthreads();
    if (tid < 128) {
        const int dir = tid >> 6, p = tid & 63;
        const size_t gp = ((size_t)(j * 2 + dir) * 64 + g) * 64 + p;
        const float lr = F.inp(I_LAMRE)[gp], li = F.inp(I_LAMIM)[gp];
        const float dt = expf(F.inp(I_LOGSTEP)[(size_t)(j * 2 + dir) * 64 + g]);
        const float mag = expf(lr * dt); float sn, cs; sincosf(li * dt, &sn, &cs);
        const cf a = mkcf(mag * cs, mag * sn);
        const float den = lr * lr + li * li; const float nr = a.x - 1.0f;
        const cf kf = mkcf((nr * lr + a.y * li) / den, (a.y * lr - nr * li) / den);
        cf pw = mkcf(1.0f, 0.0f);
        for (int n = 0; n <= 32; ++n) { PA[(dir * 33 + n) * 64 + p] = pw; pw = cmul(pw, a); }
        for (int h = 0; h < 16; ++h) { const cf bb = mkcf(F.inp(I_BRE)[gp * 16 + h], F.inp(I_BIM)[gp * 16 + h]); PB[(dir * 64 + p) * 16 + h] = cmul(kf, bb); }
        for (int h = 0; h < 16; ++h) { const size_t ci = (((size_t)(j * 2 + dir) * 64 + g) * 16 + h) * 64 + p; PCc[(dir * 16 + h) * 64 + p] = mkcf(F.inp(I_CRE)[ci], F.inp(I_CIM)[ci]); }
    }
    __syncthreads();
    for (int idx = tid; idx < 2 * 32 * 256; idx += NTHR) {
        const int h = idx & 15, hp = (idx >> 4) & 15, tau = (idx >> 8) & 31, dir = idx >> 13;
        float s = 0.f;
        for (int p = 0; p < 64; ++p) { const cf c = PCc[(dir * 16 + hp) * 64 + p], a = PA[(dir * 33 + tau) * 64 + p], bb = PB[(dir * 64 + p) * 16 + h]; const cf ca = cmul(c, a); s += ca.x * bb.x - ca.y * bb.y; }
        PK[idx] = s;
    }
    __syncthreads();
    bf16_t* M = (bf16_t*)(F.ws + WS_S5M) + (size_t)(j * 64 + g) * 512 * 768;
    const float* dsk = F.inp(I_S5D) + (size_t)j * D + g * 16;
    for (int idx = tid; idx < 512 * 768; idx += NTHR) {
        const int rho = idx / 768, kc = idx % 768;
        const int o = (rho & ~31) + perm32(rho & 31);
        const int t = o >> 4, hp = o & 15;
        float val;
        if (kc < 512) {
            const int jj = kc >> 4, h = kc & 15;
            val = 0.f;
            if (jj <= t) val += PK[((0 * 32 + (t - jj)) * 16 + hp) * 16 + h];
            if (jj >= t) val += PK[((1 * 32 + (jj - t)) * 16 + hp) * 16 + h];
            if (jj == t && h == hp) val += dsk[hp];
        } else {
            const int s = kc - 512, dir = s >> 7, im = (s >> 6) & 1, p = s & 63;
            const int n = dir == 0 ? t + 1 : 32 - t;
            const cf z = cmul(PCc[(dir * 16 + hp) * 64 + p], PA[(dir * 33 + n) * 64 + p]);
            val = im ? -z.y : z.x;
        }
        M[idx] = f2bf(val);
    }
    bf16_t* PIN = (bf16_t*)(F.ws + WS_S5PIN) + (size_t)(j * 64 + g) * 256 * 512;
    for (int idx = tid; idx < 256 * 512; idx += NTHR) {
        const int rho = idx >> 9, kc = idx & 511;
        const int s = (rho & ~31) + perm32(rho & 31);
        const int dir = s >> 7, im = (s >> 6) & 1, p = s & 63;
        const int jj = kc >> 4, h = kc & 15;
        const int n = dir == 0 ? 31 - jj : jj;
        const cf x = cmul(PA[(dir * 33 + n) * 64 + p], PB[(dir * 64 + p) * 16 + h]);
        PIN[idx] = f2bf(im ? x.y : x.x);
    }
    if (tid < 128) { const int dir = tid >> 6, p = tid & 63; const cf aT = PA[(dir * 33 + 32) * 64 + p];
        float* AT = (float*)(F.ws + WS_S5AT) + (((size_t)(j * 64 + g) * 2 + dir) * 64 + p) * 2; AT[0] = aT.x; AT[1] = aT.y; }
}

DI void mod_item(const Frame& F, int layer, int nblk) {
    LAS float* cond = (LAS float*)(F.lds);
    LAS float* red = (LAS float*)(F.lds + 20480);
    const int tid = F.tid;
    __syncthreads();
    for (int idx = tid; idx < 5 * 1024; idx += NTHR) { const int r = idx >> 10, k = idx & 1023; const float c = r < 4 ? F.inp(I_C)[r * 1024 + k] : F.inp(I_CCTX)[k]; cond[idx] = c / (1.0f + __expf(-c)); }
    __syncthreads();
    const int cq = tid & 31, kg = tid >> 5, n0 = nblk * 128;
    const float* W = F.inp(I_WADA) + (size_t)layer * 1024 * 6144 + n0 + cq * 4;
    f32x4 acc[5];
#pragma unroll
    for (int r = 0; r < 5; ++r) acc[r] = (f32x4){0.f, 0.f, 0.f, 0.f};
#pragma unroll 8
    for (int kk = 0; kk < 64; ++kk) {
        const int k = kg * 64 + kk;
        const f32x4 wv = *(const f32x4*)(W + (size_t)k * 6144);
#pragma unroll
        for (int r = 0; r < 5; ++r) acc[r] += cond[r * 1024 + k] * wv;
    }
#pragma unroll
    for (int r = 0; r < 5; ++r)
#pragma unroll
        for (int i = 0; i < 4; ++i) red[(kg * 5 + r) * 128 + cq * 4 + i] = acc[r][i];
    __syncthreads();
    for (int idx = tid; idx < 5 * 128; idx += NTHR) {
        const int r = idx >> 7, n = idx & 127;
        float s = F.inp(I_BADA)[(size_t)layer * 6144 + n0 + n];
        for (int q = 0; q < 16; ++q) s += red[(q * 5 + r) * 128 + n];
        ((float*)(F.ws + WS_MOD))[(size_t)(layer * 5 + r) * 6144 + n0 + n] = s;
    }
}

DI int phys_row(int n, int mode) {
    if (mode == 0) return (n & ~31) + inv32(n & 31);
    const int half = n >> 10, jn = n & 1023;
    return 256 * (jn >> 7) + 128 * half + 32 * ((jn & 127) >> 5) + inv32(jn & 31);
}
DI void transpose_tile(const Frame& F, const float* src, int ld, bf16_t* dst, int mode, int kt, int ntile) {
    LAS bf16_t* T = (LAS bf16_t*)F.lds;
    const int tid = F.tid, k0 = kt * 128, n0 = ntile * 128;
    __syncthreads();
#pragma unroll
    for (int q = 0; q < 8; ++q) {
        const int idx = tid + 512 * q, kr = idx >> 5, c4 = idx & 31;
        const f32x4 v = *(const f32x4*)(src + (size_t)(k0 + kr) * ld + n0 + c4 * 4);
#pragma unroll
        for (int i = 0; i < 4; ++i) T[(c4 * 4 + i) * 136 + kr] = f2bf(v[i]);
    }
    __syncthreads();
#pragma unroll
    for (int q = 0; q < 4; ++q) {
        const int idx = tid + 512 * q, nl = idx >> 4, ch = idx & 15;
        const u32x4 p = *(const LAS u32x4*)(T + nl * 136 + ch * 8);
        *(u32x4*)(dst + (size_t)phys_row(n0 + nl, mode) * 1024 + k0 + ch * 8) = p;
    }
}
DI void small_transpose(const Frame& F, const float* src, int ld, int c0, bf16_t* dst) {
    for (int idx = F.tid; idx < 32 * 1024; idx += NTHR) { const int e = idx >> 10, k = idx & 1023; dst[idx] = f2bf(src[(size_t)k * ld + c0 + e]); }
}

constexpr int PI_S5 = 128, PI_MOD = 192, PI_GLU = 2 * 128, PI_WIN = 2 * 192, PI_WOUT = 2 * 64, PI_UP = 128 * 128, PI_DN = 128 * 64, PI_SMALL = 6;
constexpr int PI_TOTAL = PI_S5 + PI_MOD + PI_GLU + PI_WIN + PI_WOUT + PI_UP + PI_DN + PI_SMALL;
DI void prologue_item(const Frame& F, int it) {
    if (it < PI_S5) { s5_precompute(F, it >> 6, it & 63); return; } it -= PI_S5;
    if (it < PI_MOD) { mod_item(F, it / 48, it % 48); return; } it -= PI_MOD;
    if (it < PI_GLU) { const int j = it >> 7, r = it & 127;
        transpose_tile(F, F.inp(I_WGLU) + (size_t)j * 1024 * 2048, 2048, (bf16_t*)(F.ws + WS_WGLU) + (size_t)j * 2048 * 1024, 1, r & 7, r >> 3); return; } it -= PI_GLU;
    if (it < PI_WIN) { const int j = it / 192, r = it % 192;
        transpose_tile(F, F.inp(I_WIN) + (size_t)j * 1024 * 3104, 3104, (bf16_t*)(F.ws + WS_WIN) + (size_t)j * 3072 * 1024, 0, r & 7, r >> 3); return; } it -= PI_WIN;
    if (it < PI_WOUT) { const int j = it >> 6, r = it & 63;
        transpose_tile(F, F.inp(I_WOUT) + (size_t)j * 1024 * 1024, 1024, (bf16_t*)(F.ws + WS_WOUT) + (size_t)j * 1024 * 1024, 0, r & 7, r >> 3); return; } it -= PI_WOUT;
    if (it < PI_UP) { const int le = it >> 7, r = it & 127;
        transpose_tile(F, F.inp(I_WUP) + (size_t)le * 1024 * 2048, 2048, (bf16_t*)(F.ws + WS_WUP) + (size_t)le * 2048 * 1024, 1, r & 7, r >> 3); return; } it -= PI_UP;
    if (it < PI_DN) { const int le = it >> 6, r = it & 63;
        transpose_tile(F, F.inp(I_WDN) + (size_t)le * 1024 * 1024, 1024, (bf16_t*)(F.ws + WS_WDN) + (size_t)le * 1024 * 1024, 0, r & 7, r >> 3); return; } it -= PI_DN;
    if (it < 4) { small_transpose(F, F.inp(I_WROUTER) + (size_t)it * 1024 * 32, 32, 0, (bf16_t*)(F.ws + WS_WR) + (size_t)it * 32 * 1024); return; }
    it -= 4;
    small_transpose(F, F.inp(I_WIN) + (size_t)it * 1024 * 3104, 3104, 3072, (bf16_t*)(F.ws + WS_WLR) + (size_t)it * 32 * 1024);
}

DI void s5_scan(const Frame& F, int j) {
    const float* E = (const float*)(F.ws + WS_E);
    bf16_t* UP = (bf16_t*)(F.ws + WS_UP);
    const float* AT = (const float*)(F.ws + WS_S5AT);
    const int sub = F.tid >> 7, t7 = F.tid & 127, dir = t7 >> 6, p = t7 & 63;
    for (int item = F.vcu + F.G * sub; item < 256; item += 4 * F.G) {
        const int b = item >> 6, g = item & 63;
        const float* at = AT + (((size_t)(j * 64 + g) * 2 + dir) * 64 + p) * 2;
        const float ar = at[0], ai = at[1];
        const float* Eg = E + (size_t)g * S5ROWS * 256 + dir * 128 + p;
        bf16_t* Ug = UP + (size_t)g * S5ROWS * 768 + 512 + dir * 128 + p;
        float sr = 0.f, si = 0.f;
#pragma unroll 1
        for (int blk = 0; blk < 33; ++blk) {
            float er[8], ei[8]; int crs[8];
#pragma unroll
            for (int q = 0; q < 8; ++q) {
                const int s = blk * 8 + q;
                int cr;
                if (s < 8) cr = 1024 + b * 8 + (dir == 0 ? s : 7 - s);
                else cr = b * 256 + (dir == 0 ? (s - 8) : 255 - (s - 8));
                crs[q] = cr;
                er[q] = Eg[(size_t)cr * 256]; ei[q] = Eg[(size_t)cr * 256 + 64];
            }
#pragma unroll
            for (int q = 0; q < 8; ++q) {
                Ug[(size_t)crs[q] * 768] = f2bf(sr); Ug[(size_t)crs[q] * 768 + 64] = f2bf(si);
                const float nr = ar * sr - ai * si + er[q], ni = ar * si + ai * sr + ei[q];
                sr = nr; si = ni;
            }
        }
    }
}

DI bf16_t* qke_ptr(const Frame& F, int dir, int which) { return (bf16_t*)(F.ws + WS_QKE) + (size_t)(dir * 3 + which) * TT * 512; }
DI void gla_gates(const Frame& F, int j) {
    LAS float* as = (LAS float*)F.lds;
    const bf16_t* P = (const bf16_t*)(F.ws + WS_P);
    const float* ALR = (const float*)(F.ws + WS_ALR);
    float* GCH = (float*)(F.ws + WS_GCH);
    const int c = F.tid;
    for (int it = F.vcu; it < 528 * 2; it += F.G) {
        const int cg = it >> 1, dir = it & 1, row0 = cg * 64;
        __syncthreads();
        for (int idx = F.tid; idx < 1024; idx += NTHR) { const int t = idx >> 4, r = idx & 15; as[idx] = ALR[(size_t)(row0 + t) * 32 + dir * 16 + r]; }
        __syncthreads();
        float w[16];
#pragma unroll
        for (int r = 0; r < 16; ++r) w[r] = F.inp(I_WA2)[((size_t)(j * 2 + dir) * 16 + r) * 512 + c];
        const float bias = F.inp(I_BA2)[(size_t)(j * 2 + dir) * 512 + c];
        float la[64]; float tot = 0.f;
#pragma unroll
        for (int t = 0; t < 64; ++t) {
            float x = bias;
#pragma unroll
            for (int r4 = 0; r4 < 4; ++r4) { const f32x4 a = *(const LAS f32x4*)(as + t * 16 + r4 * 4); x += a[0] * w[r4 * 4] + a[1] * w[r4 * 4 + 1] + a[2] * w[r4 * 4 + 2] + a[3] * w[r4 * 4 + 3]; }
            la[t] = (fminf(x, 0.f) - __logf(1.0f + __expf(-fabsf(x)))) * (1.0f / 16.0f);
            tot += la[t];
        }
        bf16_t* QD = qke_ptr(F, dir, 0); bf16_t* KD = qke_ptr(F, dir, 1); bf16_t* KE = qke_ptr(F, dir, 2);
        float pre = 0.f;
#pragma unroll
        for (int tb = 0; tb < 4; ++tb) {
            bf16_t qv[16], kv[16];
#pragma unroll
            for (int u = 0; u < 16; ++u) { const size_t row = (size_t)(row0 + tb * 16 + u); qv[u] = P[row * 3072 + c]; kv[u] = P[row * 3072 + 512 + c]; }
#pragma unroll
            for (int u = 0; u < 16; ++u) {
                const int t = tb * 16 + u;
                pre += la[t];
                const float bq = dir == 0 ? pre : (tot - pre + la[t]);
                const float ee = tot - bq;
                const size_t row = (size_t)(row0 + t);
                const float q = bf2f(qv[u]), k = bf2f(kv[u]);
                QD[row * 512 + c] = f2bf(q * 0.08838834764831845f * __expf(bq));
                KD[row * 512 + c] = f2bf(k * __expf(-bq));
                KE[row * 512 + c] = f2bf(k * __expf(ee));
            }
        }
        GCH[((size_t)cg * 2 + dir) * 512 + c] = __expf(tot);
    }
}

constexpr int GC_XSTR = 272, GC_VSTR = 80, GC_ASTR = 144;
constexpr int GC_QD = 0, GC_KD = 64 * GC_XSTR, GC_KE = 2 * 64 * GC_XSTR, GC_V = 3 * 64 * GC_XSTR, GC_BUF = 3 * 64 * GC_XSTR + 64 * GC_VSTR;
constexpr int GC_ATT = 2 * GC_BUF, GC_S = GC_ATT + 64 * GC_ASTR;
static_assert(GC_S + 128 * GC_VSTR <= LDS_MISC, "gla chunk LDS map");
DI bf16x8 tr_frag(const LAS unsigned char* base, int stride, int k0, int c0, int lane) {
    const int q = (lane & 15) >> 2, p = lane & 3, quad = lane >> 4;
    const LAS unsigned char* a = base + (k0 + quad * 8 + q) * stride + (c0 + 4 * p) * 2;
    const s16x4 lo = __builtin_amdgcn_ds_read_tr16_b64_v4i16((LAS s16x4*)a);
    const s16x4 hi = __builtin_amdgcn_ds_read_tr16_b64_v4i16((LAS s16x4*)(a + 4 * stride));
    return __builtin_shufflevector(lo, hi, 0, 1, 2, 3, 4, 5, 6, 7);
}
DI void gla_chunks(const Frame& F) {
    LAS unsigned char* lds = F.lds;
    const bf16_t* P = (const bf16_t*)(F.ws + WS_P);
    const float* GCH = (const float*)(F.ws + WS_GCH);
    const int tid = F.tid, lane = F.lane, w = F.wave, fr = lane & 15, quad = lane >> 4;
    for (int item = F.vcu; item < 256; item += F.G) {
        const int sl = item & 7, dir = (item >> 3) & 1, hd = (item >> 4) & 3, b = item >> 6;
        const bf16_t* QD = qke_ptr(F, dir, 0); const bf16_t* KD = qke_ptr(F, dir, 1); const bf16_t* KE = qke_ptr(F, dir, 2);
        bf16_t* O = (bf16_t*)(F.ws + WS_O) + (size_t)dir * TT * D;
        __syncthreads();
        for (int idx = tid; idx < 128 * GC_VSTR / 4; idx += NTHR) ((LAS unsigned*)(lds + GC_S))[idx] = 0u;
        f32x4 sacc[2]; sacc[0] = (f32x4){0.f, 0.f, 0.f, 0.f}; sacc[1] = sacc[0];
        u32x4 pq[2], pk[2], pe[2], pv;
        const int xr0 = tid >> 4, xc = tid & 15;
        const int vr = (tid & 255) >> 2, vc = tid & 3;
#define rowbase_of(s) ((s) < 4 ? TL + b * LCTX + (dir == 0 ? (s) : 3 - (s)) * 64 : b * SEQ + (dir == 0 ? ((s) - 4) : 127 - ((s) - 4)) * 64)
#define GC_LOAD(s) do { const int _rb = rowbase_of(s); \
        _Pragma("unroll") for (int _i = 0; _i < 2; ++_i) { const size_t _o = (size_t)(_rb + xr0 + 32 * _i) * 512 + hd * 128 + xc * 8; \
            pq[_i] = *(const u32x4*)(QD + _o); pk[_i] = *(const u32x4*)(KD + _o); pe[_i] = *(const u32x4*)(KE + _o); } \
        if (tid < 256) pv = *(const u32x4*)(P + (size_t)(_rb + vr) * 3072 + 1024 + hd * 256 + sl * 32 + vc * 8); } while (0)
#define GC_STORE(buf) do { LAS unsigned char* _b = lds + (buf) * GC_BUF; \
        _Pragma("unroll") for (int _i = 0; _i < 2; ++_i) { const int _o = (xr0 + 32 * _i) * GC_XSTR + xc * 16; \
            *(LAS u32x4*)(_b + GC_QD + _o) = pq[_i]; *(LAS u32x4*)(_b + GC_KD + _o) = pk[_i]; *(LAS u32x4*)(_b + GC_KE + _o) = pe[_i]; } \
        if (tid < 256) *(LAS u32x4*)(_b + GC_V + vr * GC_VSTR + vc * 16) = pv; } while (0)
        GC_LOAD(0); GC_STORE(0);
        __syncthreads();
#pragma unroll 1
        for (int s = 0; s < 132; ++s) {
            const int cur = s & 1;
            const LAS unsigned char* bq = lds + cur * GC_BUF + GC_QD; const LAS unsigned char* bk = lds + cur * GC_BUF + GC_KD;
            const LAS unsigned char* be = lds + cur * GC_BUF + GC_KE; const LAS unsigned char* bv = lds + cur * GC_BUF + GC_V;
            const int rb = rowbase_of(s);
            if (s + 1 < 132) GC_LOAD(s + 1);
            const f32x4 gv = *(const f32x4*)(GCH + ((size_t)(rb >> 6) * 2 + dir) * 512 + hd * 128 + w * 16 + quad * 4);
#pragma unroll
            for (int q2 = 0; q2 < 2; ++q2) {
                const int id = 2 * w + q2, ti = id >> 2, tj = id & 3;
                f32x4 a4 = (f32x4){0.f, 0.f, 0.f, 0.f};
#pragma unroll
                for (int kk = 0; kk < 4; ++kk) {
                    const bf16x8 af = *(const LAS bf16x8*)(bq + (ti * 16 + fr) * GC_XSTR + (kk * 32 + quad * 8) * 2);
                    const bf16x8 bf = *(const LAS bf16x8*)(bk + (tj * 16 + fr) * GC_XSTR + (kk * 32 + quad * 8) * 2);
                    a4 = __builtin_amdgcn_mfma_f32_16x16x32_bf16(af, bf, a4, 0, 0, 0);
                }
                const int jcol = tj * 16 + fr;
#pragma unroll
                for (int r = 0; r < 4; ++r) { const int irow = ti * 16 + quad * 4 + r; const bool keep = dir == 0 ? (jcol <= irow) : (jcol >= irow);
                    *(LAS bf16_t*)(lds + GC_ATT + irow * GC_ASTR + jcol * 2) = f2bf(keep ? a4[r] : 0.f); }
            }
            const int tm = w >> 1, tn = w & 1;
            f32x4 oacc = (f32x4){0.f, 0.f, 0.f, 0.f};
#pragma unroll
            for (int kk = 0; kk < 4; ++kk) {
                const bf16x8 af = *(const LAS bf16x8*)(bq + (tm * 16 + fr) * GC_XSTR + (kk * 32 + quad * 8) * 2);
                const bf16x8 bf = tr_frag(lds + GC_S, GC_VSTR, kk * 32, tn * 16, lane);
                oacc = __builtin_amdgcn_mfma_f32_16x16x32_bf16(af, bf, oacc, 0, 0, 0);
            }
            __syncthreads();
#pragma unroll
            for (int kk = 0; kk < 2; ++kk) {
                const bf16x8 af = *(const LAS bf16x8*)(lds + GC_ATT + (tm * 16 + fr) * GC_ASTR + (kk * 32 + quad * 8) * 2);
                const bf16x8 bf = tr_frag(bv, GC_VSTR, kk * 32, tn * 16, lane);
                oacc = __builtin_amdgcn_mfma_f32_16x16x32_bf16(af, bf, oacc, 0, 0, 0);
            }
#pragma unroll
            for (int r = 0; r < 4; ++r) O[(size_t)(rb + tm * 16 + quad * 4 + r) * D + hd * 256 + sl * 32 + tn * 16 + fr] = f2bf(oacc[r]);
#pragma unroll
            for (int t2 = 0; t2 < 2; ++t2) {
                f32x4 sa = sacc[t2] * gv;
#pragma unroll
                for (int kk = 0; kk < 2; ++kk) {
                    const bf16x8 af = tr_frag(be, GC_XSTR, kk * 32, w * 16, lane);
                    const bf16x8 bf = tr_frag(bv, GC_VSTR, kk * 32, t2 * 16, lane);
                    sa = __builtin_amdgcn_mfma_f32_16x16x32_bf16(af, bf, sa, 0, 0, 0);
                }
                sacc[t2] = sa;
#pragma unroll
                for (int r = 0; r < 4; ++r) *(LAS bf16_t*)(lds + GC_S + (w * 16 + quad * 4 + r) * GC_VSTR + (t2 * 16 + fr) * 2) = f2bf(sa[r]);
            }
            if (s + 1 < 132) GC_STORE(cur ^ 1);
            __syncthreads();
        }
#undef GC_LOAD
#undef GC_STORE
#undef rowbase_of
    }
}

DI void gla_prep(const Frame& F, int j) {
    const bf16_t* OF = (const bf16_t*)(F.ws + WS_O); const bf16_t* OB = OF + (size_t)TT * D;
    const bf16_t* P = (const bf16_t*)(F.ws + WS_P);
    bf16_t* YG = (bf16_t*)(F.ws + WS_YG);
    const int lane = F.lane;
    const f32x4 ng = *(const f32x4*)(F.inp(I_NORMG) + (size_t)j * 256 + 4 * lane);
    for (int row = F.vcu * 8 + F.wave; row < TT; row += F.G * 8) {
#pragma unroll
        for (int i = 0; i < 4; ++i) {
            const size_t o = (size_t)row * D + 256 * i + 4 * lane;
            const u32x2 a = *(const u32x2*)(OF + o), bb = *(const u32x2*)(OB + o);
            const u32x2 gg = *(const u32x2*)(P + (size_t)row * 3072 + 2048 + 256 * i + 4 * lane);
            f32x4 v; v[0] = bf_lo(a[0]) + bf_lo(bb[0]); v[1] = bf_hi(a[0]) + bf_hi(bb[0]); v[2] = bf_lo(a[1]) + bf_lo(bb[1]); v[3] = bf_hi(a[1]) + bf_hi(bb[1]);
            const float ms = wave_sum(v[0] * v[0] + v[1] * v[1] + v[2] * v[2] + v[3] * v[3]) * (1.0f / 256.0f);
            const float rs = rsqrtf(ms + LN_EPS);
            f32x4 g4; g4[0] = bf_lo(gg[0]); g4[1] = bf_hi(gg[0]); g4[2] = bf_lo(gg[1]); g4[3] = bf_hi(gg[1]);
            f32x4 y;
#pragma unroll
            for (int q = 0; q < 4; ++q) y[q] = v[q] * rs * ng[q] * (g4[q] * sigmoidf_(g4[q]));
            u32x2 p; p[0] = cvt_pk_bf16(y[0], y[1]); p[1] = cvt_pk_bf16(y[2], y[3]);
            *(u32x2*)(YG + o) = p;
        }
    }
}

#ifndef DUP_MASK
#define DUP_MASK 0
#endif
#define DUPN(id) ((DUP_MASK >> (id)) & 1 ? 2 : 1)
#ifndef STOP_AT
#define STOP_AT 0
#endif
DI void dump_h(const Frame& F) {
    const f32x4* H = (const f32x4*)(F.ws + WS_H); f32x4* O = (f32x4*)F.out;
    for (size_t i = (size_t)F.vcu * NTHR + F.tid; i < (size_t)TL * D / 4; i += (size_t)F.G * NTHR) O[i] = H[i];
}
#define STOP_CHECK(code) do { if (STOP_AT == (code)) { const Frame L = launder(F); dump_h(L); return; } } while (0)
#ifdef PROBE
#define STAMP(id) do { if (blockIdx.x == 0 && threadIdx.x == 0) { const unsigned long long _n = __builtin_amdgcn_s_memrealtime(); volatile LAS unsigned* _d = (volatile LAS unsigned*)(F.lds + LDS_MISC + 512); \
    _d[(id)] += (unsigned)(_n - *(volatile LAS unsigned long long*)(F.lds + LDS_MISC + 768)); *(volatile LAS unsigned long long*)(F.lds + LDS_MISC + 768) = _n; } } while (0)
#else
#define STAMP(id) do { } while (0)
#endif
__global__ void __launch_bounds__(NTHR, 2) fwd_kernel(Args args) {
    extern __shared__ __attribute__((aligned(16))) unsigned char lds_raw[];
    Frame F;
    F.lds = (LAS unsigned char*)lds_raw; F.ws = args.ws; F.in = (inarr_t)__builtin_amdgcn_kernarg_segment_ptr(); F.out = args.out;
    F.tid = threadIdx.x; F.lane = F.tid & 63; F.wave = __builtin_amdgcn_readfirstlane(F.tid >> 6);
    F.G = gridDim.x; { const int bx = blockIdx.x; F.vcu = (F.G % 8 == 0) ? (bx % 8) * (F.G / 8) + bx / 8 : bx; }
    for (int u = F.tid; u < 1024 / 4; u += NTHR) ((LAS unsigned*)(F.lds + LDS_MISC))[u] = 0u;
    __syncthreads();
    F.ws = (unsigned char*)(GBL unsigned char*)(unsigned long long)F.ws; F.out = (float*)(GBL float*)(unsigned long long)F.out;
    XcdBarrier bar = xcd_barrier_post((unsigned*)(F.ws + WS_CTL), (volatile LAS unsigned*)(F.lds + LDS_MISC));
#define GRID_BAR_() do { XcdBarrier _b = bar; { unsigned long long _x = (unsigned long long)_b.bar; asm volatile("" : "+s"(_x)); _b.bar = (unsigned*)(GBL unsigned*)_x; } asm volatile("" : "+s"(_b.x)); xcd_barrier(_b); } while (0)
#define GRID_BAR(id) do { GRID_BAR_(); STAMP(id); } while (0)
#ifdef PROBE
    if (blockIdx.x == 0 && threadIdx.x == 0) *(volatile LAS unsigned long long*)(F.lds + LDS_MISC + 768) = __builtin_amdgcn_s_memrealtime();
#endif
    LAS int* mt = (LAS int*)(F.lds + LDS_MISC + 256);
    volatile LAS int* qslot = (volatile LAS int*)(F.lds + LDS_MISC + 64);

    for (int _r = 0; _r < DUPN(0); ++_r) { if (_r) GRID_BAR(0);
    for (;;) {
        const Frame L = launder(F);
        __syncthreads();
        if (L.tid == 0) *qslot = (int)__hip_atomic_fetch_add((unsigned*)(L.ws + WS_CTL) + CW_QUEUE + 32 * _r, 1u, __ATOMIC_RELAXED, __HIP_MEMORY_SCOPE_AGENT);
        __syncthreads();
        const int q = __builtin_amdgcn_readfirstlane(*qslot);
        if (q < PI_S5 + PI_MOD) { prologue_item(L, q); continue; }
        const int base = PI_S5 + PI_MOD + (q - (PI_S5 + PI_MOD)) * 8;
        if (base >= PI_TOTAL) break;
#pragma unroll 1
        for (int it = base; it < base + 8 && it < PI_TOTAL; ++it) prologue_item(L, it);
    }
    }
    GRID_BAR(0);
    { const Frame L = launder(F); row_pass<IN_INIT, OUT_S5>(L, TT, 0, nullptr, nullptr, 0, 0, nullptr, nullptr, 0); }
    GRID_BAR(1);
#pragma unroll 1
    for (int layer = 0; layer < DEPTH; ++layer) {
        const int j = layer >> 1;
        if ((layer & 1) == 0) {
for (int _r = 0; _r < DUPN(2); ++_r) { if (_r) GRID_BAR(2);
            { const Frame L = launder(F); ProbS5E p{(const bf16_t*)(L.ws + WS_UP), (const bf16_t*)(L.ws + WS_S5PIN) + (size_t)j * 64 * 256 * 512, (float*)(L.ws + WS_E), L.G, L.vcu}; g8::gemm_phase(L.lds, L.tid, p); }
}
            GRID_BAR(2);
for (int _r = 0; _r < DUPN(3); ++_r) { if (_r) GRID_BAR(3);
            { const Frame L = launder(F); s5_scan(L, j); }
}
            GRID_BAR(3);
for (int _r = 0; _r < DUPN(4); ++_r) { if (_r) GRID_BAR(4);
            { const Frame L = launder(F); ProbS5Y p{(const bf16_t*)(L.ws + WS_UP), (const bf16_t*)(L.ws + WS_S5M) + (size_t)j * 64 * 512 * 768, (bf16_t*)(L.ws + WS_YG), L.G, L.vcu}; g8::gemm_phase(L.lds, L.tid, p); }
}
            GRID_BAR(4);
            { const Frame L = launder(F); ProbGLU p{(const bf16_t*)(L.ws + WS_YG), (const bf16_t*)(L.ws + WS_WGLU) + (size_t)j * 2048 * 1024, (float*)(L.ws + WS_H), (const float*)(L.ws + WS_MOD) + (size_t)layer * 5 * 6144, L.G, L.vcu}; g8::gemm_phase(L.lds, L.tid, p); }
        } else {
for (int _r = 0; _r < DUPN(10); ++_r) { if (_r) GRID_BAR(10);
            { const Frame L = launder(F); ProbProj p{(const bf16_t*)(L.ws + WS_UB), (const bf16_t*)(L.ws + WS_WIN) + (size_t)j * 3072 * 1024, (bf16_t*)(L.ws + WS_P), L.G, L.vcu}; g8::gemm_phase(L.lds, L.tid, p); }
}
            GRID_BAR(10);
for (int _r = 0; _r < DUPN(11); ++_r) { if (_r) GRID_BAR(11);
            { const Frame L = launder(F); gla_gates(L, j); }
}
            GRID_BAR(11);
for (int _r = 0; _r < DUPN(12); ++_r) { if (_r) GRID_BAR(12);
            { const Frame L = launder(F); gla_chunks(L); }
}
            GRID_BAR(12);
for (int _r = 0; _r < DUPN(13); ++_r) { if (_r) GRID_BAR(13);
            { const Frame L = launder(F); gla_prep(L, j); }
}
            GRID_BAR(13);
            { const Frame L = launder(F); ProbOut p{(const bf16_t*)(L.ws + WS_YG), (const bf16_t*)(L.ws + WS_WOUT) + (size_t)j * 1024 * 1024, (float*)(L.ws + WS_H), (const float*)(L.ws + WS_MOD) + (size_t)layer * 5 * 6144, layer == 3 ? TL / 256 : TT / 256, L.G, L.vcu}; g8::gemm_phase(L.lds, L.tid, p); }
        }
        GRID_BAR((layer & 1) ? 14 : 5);
        { const Frame L = launder(F);
          row_pass<IN_LN, OUT_ROUTER>(L, layer == 3 ? TL : TT, layer, L.inp(I_LN1G) + (size_t)layer * D, L.inp(I_LN1B) + (size_t)layer * D, layer, 3,
                                      (const bf16_t*)(L.ws + WS_WR) + (size_t)layer * 32 * 1024, L.inp(I_BROUTER) + (size_t)layer * 32, layer); }
        GRID_BAR(6);
        if (STOP_AT != 0 && STOP_AT == layer * 2 + 1) { const Frame L = launder(F); dump_h(L); return; }
for (int _r = 0; _r < DUPN(7); ++_r) { if (_r) GRID_BAR(7);
        { const Frame L = launder(F);
          __syncthreads();
          if (L.tid == 0) { const unsigned* cw = (const unsigned*)(L.ws + WS_CTL) + CW_CNT + layer * 32; int acc = 0; mt[32] = 0; for (int e = 0; e < 32; ++e) { const int c = (int)cw[e]; mt[e] = c; acc += (c + 255) >> 8; mt[33 + e] = acc; } }
          __syncthreads();
          ProbUp p{(const bf16_t*)(L.ws + WS_UB), (const bf16_t*)(L.ws + WS_WUP) + (size_t)layer * 32 * 2048 * 1024, L.inp(I_BUP) + (size_t)layer * 32 * 2048, (const int*)(L.ws + WS_TOKL),
                   (bf16_t*)(L.ws + WS_ACT), MoeTab{mt}, L.G, L.vcu}; g8::gemm_phase(L.lds, L.tid, p); }
}
        GRID_BAR(7);
for (int _r = 0; _r < DUPN(8); ++_r) { if (_r) GRID_BAR(8);
        { const Frame L = launder(F);
          ProbDown p{(const bf16_t*)(L.ws + WS_ACT), (const bf16_t*)(L.ws + WS_WDN) + (size_t)layer * 32 * 1024 * 1024, L.inp(I_BDN) + (size_t)layer * 32 * 1024, (const int*)(L.ws + WS_TOKL),
                     (const float*)(L.ws + WS_GATEL), (bf16_t*)(L.ws + WS_FEXP), MoeTab{mt}, L.G, L.vcu}; g8::gemm_phase(L.lds, L.tid, p); }
}
        GRID_BAR(8);
        { const Frame L = launder(F);
          const float* l2g = L.inp(I_LN2G) + (size_t)layer * D; const float* l2b = L.inp(I_LN2B) + (size_t)layer * D;
          if (layer == 3) row_pass<IN_COMBINE, OUT_FINAL>(L, TL, layer, l2g, l2b, 0, 0, nullptr, nullptr, 0);
          else if (layer & 1) row_pass<IN_COMBINE, OUT_S5>(L, TT, layer, l2g, l2b, layer + 1, 0, nullptr, nullptr, 0);
          else row_pass<IN_COMBINE, OUT_CMLR>(L, TT, layer, l2g, l2b, layer + 1, 0, (const bf16_t*)(L.ws + WS_WLR) + (size_t)((layer + 1) >> 1) * 32 * 1024, nullptr, 0); }
        if (layer < 3) GRID_BAR(9);
#ifdef PROBE
        else GRID_BAR(9);
#endif
        if (STOP_AT != 0 && STOP_AT == layer * 2 + 2) { const Frame L = launder(F); dump_h(L); return; }
    }
#ifdef PROBE
    {
        unsigned* pw = (unsigned*)(F.ws + WS_CTL) + 4096;
        if (blockIdx.x == 0 && threadIdx.x == 0) { volatile LAS unsigned* d = (volatile LAS unsigned*)(F.lds + LDS_MISC + 512); pw[0] = d[PROBE_A]; pw[1] = d[PROBE_B]; }
        GRID_BAR_();
        const float va = sqrtf((float)pw[0] * 0.01f * (float)(PROBE_SA)), vb = (float)pw[1] * 0.01f * (float)(PROBE_SB);
        f32x4* O = (f32x4*)F.out;
        for (size_t i = (size_t)blockIdx.x * NTHR + threadIdx.x; i < (size_t)TL * D / 4; i += (size_t)gridDim.x * NTHR) { f32x4 v = (f32x4){va, va, va, va}; if (i == 0) v[0] = vb; O[i] = v; }
    }
#endif
}

extern "C" void kernel_launch(void* const* d_in, const int* in_sizes, int n_in, void* d_out, int out_size, void* d_ws, size_t ws_size, hipStream_t stream) {
    static int grid = 0;
    if (grid == 0) {
        if (n_in != 30 || out_size != TL * D || ws_size < WS_END) { fprintf(stderr, "kernel_launch: unexpected shapes (n_in %d out %d ws %zu need %zu)\n", n_in, out_size, ws_size, (size_t)WS_END); grid = -1; return; }
        int dev = 0, cus = 0, per_cu = 0;
        if (hipGetDevice(&dev) != hipSuccess || hipDeviceGetAttribute(&cus, hipDeviceAttributeMultiprocessorCount, dev) != hipSuccess) { grid = -1; return; }
        if (hipFuncSetAttribute((const void*)fwd_kernel, hipFuncAttributeMaxDynamicSharedMemorySize, LDS_BYTES) != hipSuccess) { fprintf(stderr, "kernel_launch: hipFuncSetAttribute failed\n"); grid = -1; return; }
        if (hipOccupancyMaxActiveBlocksPerMultiprocessor(&per_cu, (const void*)fwd_kernel, NTHR, LDS_BYTES) != hipSuccess || per_cu < 1) { fprintf(stderr, "kernel_launch: occupancy query says %d\n", per_cu); }
        (void)hipGetLastError();
        grid = cus;
    }
    if (grid < 0) return;
    (void)in_sizes;
    if (hipMemsetAsync((char*)d_ws + WS_CTL, 0, CTL_BYTES, stream) != hipSuccess) return;
    Args a{};
    for (int i = 0; i < 30; ++i) a.in[i] = (const float*)d_in[i];
    a.out = (float*)d_out; a.ws = (unsigned char*)d_ws;
    hipLaunchKernelGGL(fwd_kernel, dim3(grid), dim3(NTHR), LDS_BYTES, stream, a);
}
```

```cpp
#include <hip/hip_runtime.h>
#include <cstdio>
#include <cstdint>

#define LAS __attribute__((address_space(3)))
#define GBL __attribute__((address_space(1)))
#define DI __device__ __forceinline__
typedef unsigned short bf16_t;
typedef short bf16x8 __attribute__((ext_vector_type(8)));
typedef short s16x4 __attribute__((ext_vector_type(4)));
typedef float f32x4 __attribute__((ext_vector_type(4)));
typedef float f32x16 __attribute__((ext_vector_type(16)));
typedef unsigned u32x4 __attribute__((ext_vector_type(4)));
typedef unsigned u32x2 __attribute__((ext_vector_type(2)));

constexpr int D = 1024, NB = 4, SEQ = 8192, LCTX = 256, DEPTH = 4;
constexpr int TL = NB * SEQ, TC = NB * LCTX, TT = TL + TC;
constexpr int NTHR = 512;
constexpr int S5T = 32;
constexpr int S5ROWS = 1280;
constexpr int S5VALID = 1056;
constexpr int NEXP = 32, TOPK = 4;
constexpr int ACT_ROWS = TT * TOPK + NEXP * 256;
constexpr float DN_ALPHA = 1.6817928305074292f;
constexpr float LN_EPS = 1e-5f;
constexpr int LDS_BYTES = 147456;
constexpr int LDS_MISC = LDS_BYTES - 1024;

constexpr size_t al256(size_t x) { return (x + 255) & ~(size_t)255; }
constexpr size_t CTL_BYTES = 131072;
constexpr size_t WS_CTL   = 0;
constexpr size_t WS_MOD   = WS_CTL + CTL_BYTES;
constexpr size_t WS_H     = al256(WS_MOD + (size_t)DEPTH * 5 * 6144 * 4);
constexpr size_t WS_UB    = al256(WS_H + (size_t)TT * D * 4);
constexpr size_t WS_UP    = al256(WS_UB + (size_t)TT * D * 2);
constexpr size_t WS_E     = al256(WS_UP + (size_t)64 * S5ROWS * 768 * 2);
constexpr size_t WS_YG    = al256(WS_E + (size_t)64 * S5ROWS * 256 * 4);
constexpr size_t WS_P     = al256(WS_YG + (size_t)TT * D * 2);
constexpr size_t WS_ALR   = al256(WS_P + (size_t)TT * 3072 * 2);
constexpr size_t WS_QKE   = al256(WS_ALR + (size_t)TT * 32 * 4);
constexpr size_t WS_GCH   = al256(WS_QKE + (size_t)6 * TT * 512 * 2);
constexpr size_t WS_O     = al256(WS_GCH + (size_t)528 * 2 * 512 * 4);
constexpr size_t WS_TOKL  = al256(WS_O + (size_t)2 * TT * D * 2);
constexpr size_t WS_GATEL = al256(WS_TOKL + (size_t)NEXP * TT * 4);
constexpr size_t WS_ACT   = al256(WS_GATEL + (size_t)NEXP * TT * 4);
constexpr size_t WS_UB8   = al256(WS_ACT + (size_t)ACT_ROWS * D);
constexpr size_t WS_FEXP  = al256(WS_UB8 + (size_t)TT * D);
constexpr size_t WS_WGLU  = al256(WS_FEXP + (size_t)TT * 4 * D * 2);
constexpr size_t WS_WIN   = al256(WS_WGLU + (size_t)2 * 2048 * D * 2);
constexpr size_t WS_WOUT  = al256(WS_WIN + (size_t)2 * 3072 * D * 2);
constexpr size_t WS_WUP   = al256(WS_WOUT + (size_t)2 * D * D * 2);
constexpr size_t WS_WDN   = al256(WS_WUP + (size_t)DEPTH * NEXP * 2048 * D);
constexpr size_t WS_WR    = al256(WS_WDN + (size_t)DEPTH * NEXP * D * D);
constexpr size_t WS_WLR   = al256(WS_WR + (size_t)DEPTH * 32 * D * 2);
constexpr size_t WS_S5M   = al256(WS_WLR + (size_t)2 * 32 * D * 2);
constexpr size_t WS_S5PIN = al256(WS_S5M + (size_t)2 * 64 * 512 * 768 * 2);
constexpr size_t WS_S5AT  = al256(WS_S5PIN + (size_t)2 * 64 * 256 * 512 * 2);
constexpr size_t WS_END   = al256(WS_S5AT + (size_t)2 * 64 * 2 * 64 * 2 * 4);

#define CW_QUEUE 3520
#define CW_CNT   3584

#define XB_TMO      128
#define XB_XCNT(j)  (256  + 64 * (j))
#define XB_XSUB(j)  (1280 + 64 * (j))
#define XB_XGEN(j)  (2304 + 64 * (j))
#define XB_TOP      3328
#define XB_TOPGEN   3392
#define XCD_BAR_WORDS 3456
#define XB_SPIN_CAP (1u << 18)

__device__ __forceinline__ unsigned xb_ld(unsigned* p)              { return __hip_atomic_load(p, __ATOMIC_RELAXED, __HIP_MEMORY_SCOPE_AGENT); }
__device__ __forceinline__ unsigned xb_add(unsigned* p, unsigned v) { return __hip_atomic_fetch_add(p, v, __ATOMIC_RELAXED, __HIP_MEMORY_SCOPE_AGENT); }
__device__ __forceinline__ unsigned xb_xcc_id() { return (unsigned)__builtin_amdgcn_s_getreg((3 << 11) | 20) & 0xFu; }
#define XB_SPIN(cond, bar) do { unsigned _sp = 0; while (cond) { __builtin_amdgcn_s_sleep(1); \
    if ((++_sp & 255u) == 0u) { if (xb_ld(&(bar)[XB_TMO])) break; if (_sp > XB_SPIN_CAP) { atomicAdd(&(bar)[XB_TMO], 1u); break; } } } } while (0)

struct XcdBarrier { unsigned* bar; unsigned x; volatile LAS unsigned* st; };

__device__ __forceinline__ XcdBarrier xcd_barrier_post(unsigned* bar, volatile LAS unsigned* st) {
    XcdBarrier b; b.bar = bar; b.x = xb_xcc_id(); b.st = st;
    if (threadIdx.x == 0) (void)xb_add(&bar[XB_XCNT(b.x)], 1u);
    return b;
}
__device__ __forceinline__ void xcd_barrier_complete(unsigned* bar, unsigned x, unsigned& nloc, unsigned& nx) {
    const unsigned G = gridDim.x * gridDim.y * gridDim.z;
    unsigned sum, cnt, mine, sp = 0u;
    for (;;) {
        sum = 0u; cnt = 0u; mine = 0u;
#pragma unroll
        for (unsigned j = 0; j < 16; ++j) { const unsigned c = xb_ld(&bar[XB_XCNT(j)]); sum += c; cnt += (c > 0u) ? 1u : 0u; mine = (j == x) ? c : mine; }
        if (sum == G) break;
        __builtin_amdgcn_s_sleep(1);
        if ((++sp & 255u) == 0u) { if (xb_ld(&bar[XB_TMO])) break; if (sp > XB_SPIN_CAP) { atomicAdd(&bar[XB_TMO], 1u); break; } }
    }
    nloc = mine > 0u ? mine : 1u; nx = cnt > 0u ? cnt : 1u;
}
__device__ __forceinline__ void xcd_barrier(const XcdBarrier& b) {
    asm volatile("s_waitcnt vmcnt(0)" ::: "memory");
    __syncthreads();
    if (threadIdx.x == 0) {
        unsigned* bar = b.bar;
        __builtin_amdgcn_s_waitcnt(0);
        unsigned nloc = b.st[0], nx = b.st[1];
        if (nloc == 0u) { xcd_barrier_complete(bar, b.x, nloc, nx); b.st[0] = nloc; b.st[1] = nx; }
        const unsigned old = xb_add(&bar[XB_XSUB(b.x)], 1u);
        const unsigned gen = old / nloc;
        if (old + 1u == (gen + 1u) * nloc) {
            __builtin_amdgcn_fence(__ATOMIC_RELEASE, "agent");
            asm volatile("s_waitcnt vmcnt(0)" ::: "memory");
            const unsigned og = xb_add(&bar[XB_TOP], 1u);
            const unsigned tg = og / nx;
            if (og + 1u == (tg + 1u) * nx) xb_add(&bar[XB_TOPGEN], 1u);
            else XB_SPIN(xb_ld(&bar[XB_TOPGEN]) == tg, bar);
            __builtin_amdgcn_fence(__ATOMIC_ACQUIRE, "agent");
            xb_add(&bar[XB_XGEN(b.x)], 1u);
            asm volatile("s_waitcnt vmcnt(0)" ::: "memory");
        } else {
            XB_SPIN(xb_ld(&bar[XB_XGEN(b.x)]) == gen, bar);
            __builtin_amdgcn_fence(__ATOMIC_ACQUIRE, "agent");
            asm volatile("s_waitcnt vmcnt(0)" ::: "memory");
        }
    }
    __syncthreads();
}

typedef float f32x2_t __attribute__((ext_vector_type(2)));
typedef __bf16 bf16x2_t __attribute__((ext_vector_type(2)));
DI unsigned cvt_pk_bf16(float lo, float hi) { f32x2_t v; v.x = lo; v.y = hi; return __builtin_bit_cast(unsigned, __builtin_convertvector(v, bf16x2_t)); }
DI unsigned pack_fp8x4(float a, float b, float c, float d) { unsigned w = 0u; w = __builtin_amdgcn_cvt_pk_fp8_f32(a, b, w, false); w = __builtin_amdgcn_cvt_pk_fp8_f32(c, d, w, true); return w; }
DI float bf_lo(unsigned u) { return __uint_as_float(u << 16); }
DI float bf_hi(unsigned u) { return __uint_as_float(u & 0xffff0000u); }
DI float bf2f(bf16_t b) { return __uint_as_float(((unsigned)b) << 16); }
DI bf16_t f2bf(float f) { return (bf16_t)(cvt_pk_bf16(f, 0.f) & 0xffffu); }
DI float wave_sum(float v) {
#pragma unroll
    for (int m = 32; m >= 1; m >>= 1) v += __shfl_xor(v, m, 64);
    return v;
}
DI float sigmoidf_(float x) { return 1.0f / (1.0f + __expf(-x)); }
DI float gelu_tanh(float x) { const float z = 0.7978845608028654f * (x + 0.044715f * x * x * x); const float t = 1.0f - 2.0f / (__expf(2.0f * z) + 1.0f); return 0.5f * x * (1.0f + t); }
DI int perm32(int rho) { return 8 * ((rho >> 2) & 3) + 4 * (rho >> 4) + (rho & 3); }
DI int inv32(int o) { return 16 * ((o >> 2) & 1) + 4 * (o >> 3) + (o & 3); }

namespace g8 {
constexpr int BM = 256, BK = 64, HALF = 128, HTB = HALF * BK * 2, STAGE_BYTES = 8 * HTB;
DI int lds_byte(int r, int c) { const int st = (r >> 4) * 2 + (c >> 5), rr = r & 15, cc = c & 31, ob = rr * 64 + cc * 2; return st * 1024 + (ob ^ (((ob >> 9) & 1) << 5)); }
DI void stage_rc(int b, int& R, int& C) { const int st = b / 1024, sb = b % 1024, swz = sb ^ (((sb >> 9) & 1) << 5); R = (st >> 1) * 16 + swz / 64; C = (st & 1) * 32 + (swz % 64) / 2; }

typedef f32x4 Acc[2][2][4][2];
typedef int v8i_t __attribute__((ext_vector_type(8)));
typedef short s16x16_t __attribute__((ext_vector_type(16)));
DI bf16x8 lo8(v8i_t v) { const s16x16_t s = __builtin_bit_cast(s16x16_t, v); return __builtin_shufflevector(s, s, 0, 1, 2, 3, 4, 5, 6, 7); }
DI bf16x8 hi8(v8i_t v) { const s16x16_t s = __builtin_bit_cast(s16x16_t, v); return __builtin_shufflevector(s, s, 8, 9, 10, 11, 12, 13, 14, 15); }
DI v8i_t cat8(bf16x8 a, bf16x8 b) { return __builtin_bit_cast(v8i_t, __builtin_shufflevector(a, b, 0, 1, 2, 3, 4, 5, 6, 7, 8, 9, 10, 11, 12, 13, 14, 15)); }

template <class P>
DI void gemm_phase(LAS unsigned char* lds, const int tid, P& prob) {
    const int wid = __builtin_amdgcn_readfirstlane(tid >> 6), lane = tid & 63, wr = wid >> 2, wc = wid & 3, fr = lane & 15, fq = lane >> 4;
    const int nt = prob.Kbytes() / (BK * 2), lda = prob.ldaB(), ldb = prob.ldbB();
    unsigned cvA[2][2], nvA[2][2], voffB[2];
#pragma unroll
    for (int i = 0; i < 2; ++i) { int R, C; stage_rc(tid * 16 + i * 8192, R, C);
        voffB[i] = (unsigned)(R * ldb + C * 2);
        cvA[0][i] = (unsigned)(R * lda + C * 2); cvA[1][i] = (unsigned)((R + HALF) * lda + C * 2);
        nvA[0][i] = cvA[0][i]; nvA[1][i] = cvA[1][i]; }
    const size_t kstep = (size_t)(BK * 2);
    const size_t hstepB = (size_t)HALF * ldb;
    const unsigned ldsw = (unsigned)wid * 1024u;
    const int aoff = lds_byte(wr * 64 + fr, fq * 8), boff = lds_byte(wc * 32 + fr, fq * 8);
#define G8_SA(b, h) (((b) * 2 + (h)) * HTB)
#define G8_SB(b, h) ((4 + (b) * 2 + (h)) * HTB)
#define G8_STAGE(bufoff, gbase, voff) do { _Pragma("unroll") for (int _i = 0; _i < 2; ++_i) \
        __builtin_amdgcn_global_load_lds((const unsigned*)((const char*)(gbase) + (voff)[_i]), (LAS unsigned*)(lds + (bufoff) + ldsw + _i * 8192), 16, 0, 0); } while (0)
#define G8_STAGE_SEL(bufoff, gbase, h, sel) do { _Pragma("unroll") for (int _i = 0; _i < 2; ++_i) { const unsigned _vo = (P::GATHER && (sel)) ? nvA[h][_i] : cvA[h][_i]; \
        __builtin_amdgcn_global_load_lds((const unsigned*)((const char*)(gbase) + _vo), (LAS unsigned*)(lds + (bufoff) + ldsw + _i * 8192), 16, 0, 0); } } while (0)
#define G8_LDA(dst, b, h) do { _Pragma("unroll") for (int m = 0; m < 4; ++m) dst[m] = cat8(*(const LAS bf16x8*)(lds + G8_SA(b, h) + aoff + m * 2048), *(const LAS bf16x8*)(lds + G8_SA(b, h) + aoff + m * 2048 + 1024)); } while (0)
#define G8_LDB(dst, b, h) do { _Pragma("unroll") for (int n = 0; n < 2; ++n) dst[n] = cat8(*(const LAS bf16x8*)(lds + G8_SB(b, h) + boff + n * 2048), *(const LAS bf16x8*)(lds + G8_SB(b, h) + boff + n * 2048 + 1024)); } while (0)
#define G8_MMA(ai, bj, At, Bt) do { __builtin_amdgcn_s_setprio(1); \
        if (P::FP8) { _Pragma("unroll") for (int m = 0; m < 4; ++m) _Pragma("unroll") for (int n = 0; n < 2; ++n) \
            asm volatile("v_mfma_f32_16x16x128_f8f6f4 %0, %1, %2, %0" : "+v"(acc[ai][bj][m][n]) : "v"(Bt[n]), "v"(At[m])); } \
        else { _Pragma("unroll") for (int m = 0; m < 4; ++m) _Pragma("unroll") for (int n = 0; n < 2; ++n) { \
            acc[ai][bj][m][n] = __builtin_amdgcn_mfma_f32_16x16x32_bf16(lo8(Bt[n]), lo8(At[m]), acc[ai][bj][m][n], 0, 0, 0); \
            acc[ai][bj][m][n] = __builtin_amdgcn_mfma_f32_16x16x32_bf16(hi8(Bt[n]), hi8(At[m]), acc[ai][bj][m][n], 0, 0, 0); } } \
        __builtin_amdgcn_s_setprio(0); } while (0)
#define G8_WAIT_V(n) asm volatile("s_waitcnt vmcnt(" #n ")" ::: "memory")
#define G8_WAIT_L(n) asm volatile("s_waitcnt lgkmcnt(" #n ")" ::: "memory")
#define G8_BAR __builtin_amdgcn_s_barrier()
#define G8_SCHED __builtin_amdgcn_sched_barrier(0)
    typename P::Unit cur, nxt; int ui = 0;
    if (!prob.next(0, cur)) return;
    Acc acc;
#pragma unroll
    for (int a = 0; a < 2; ++a)
#pragma unroll
        for (int b = 0; b < 2; ++b)
#pragma unroll
            for (int m = 0; m < 4; ++m)
#pragma unroll
                for (int n = 0; n < 2; ++n) acc[a][b][m][n] = (f32x4){0.f, 0.f, 0.f, 0.f};
    v8i_t At[4], B0[2], B1[2];
    const char* cA = cur.a; const char* cB = cur.b;
    if (P::GATHER) prob.gather(cur, tid, cvA);
    G8_STAGE(G8_SB(0, 0), cB, voffB); G8_STAGE(G8_SA(0, 0), cA, cvA[0]); G8_STAGE(G8_SB(0, 1), cB + hstepB, voffB); G8_STAGE(G8_SA(0, 1), cA, cvA[1]);
    if (wr == 1) G8_BAR;
    G8_WAIT_V(4); G8_BAR;
    G8_STAGE(G8_SB(1, 0), cB + kstep, voffB); G8_STAGE(G8_SA(1, 0), cA + kstep, cvA[0]); G8_STAGE(G8_SB(1, 1), cB + hstepB + kstep, voffB);
    G8_WAIT_V(6); G8_BAR;
    for (;;) {
        const bool has_next = prob.next(ui + 1, nxt);
        const char* nA = has_next ? nxt.a : cA; const char* nB = has_next ? nxt.b : cB;
        if (P::GATHER) { if (has_next) prob.gather(nxt, tid, nvA); else {
#pragma unroll
            for (int h = 0; h < 2; ++h)
#pragma unroll
                for (int i = 0; i < 2; ++i) nvA[h][i] = cvA[h][i]; } }
#pragma unroll 1
        for (int t = 0; t < nt; t += 2) {
            const bool last = (t == nt - 2);
            const char* a1 = cA + (size_t)(t + 1) * kstep;
            const char* a2 = last ? nA : cA + (size_t)(t + 2) * kstep; const char* b2 = last ? nB : cB + (size_t)(t + 2) * kstep;
            const char* a3 = a2 + kstep; const char* b3 = b2 + kstep;
            G8_LDB(B0, 0, 0); G8_SCHED; G8_LDA(At, 0, 0); G8_STAGE(G8_SA(1, 1), a1, cvA[1]);
            G8_WAIT_L(8); G8_BAR; G8_WAIT_L(0); G8_MMA(0, 0, At, B0); G8_BAR; G8_SCHED;
            G8_LDB(B1, 0, 1); G8_STAGE(G8_SB(0, 0), b2, voffB);
            G8_BAR; G8_WAIT_L(0); G8_MMA(0, 1, At, B1); G8_BAR;
            G8_LDA(At, 0, 1); G8_STAGE_SEL(G8_SA(0, 0), a2, 0, last);
            G8_BAR; G8_WAIT_L(0); G8_MMA(1, 0, At, B0); G8_BAR; G8_SCHED;
            G8_STAGE(G8_SB(0, 1), b2 + hstepB, voffB);
            G8_WAIT_V(6); G8_BAR; G8_MMA(1, 1, At, B1); G8_BAR;
            G8_LDB(B0, 1, 0); G8_SCHED; G8_LDA(At, 1, 0); G8_STAGE_SEL(G8_SA(0, 1), a2, 1, last);
            G8_WAIT_L(8); G8_BAR; G8_WAIT_L(0); G8_MMA(0, 0, At, B0); G8_BAR; G8_SCHED;
            G8_LDB(B1, 1, 1); G8_STAGE(G8_SB(1, 0), b3, voffB);
            G8_BAR; G8_WAIT_L(0); G8_MMA(0, 1, At, B1); G8_BAR;
            G8_LDA(At, 1, 1); G8_STAGE_SEL(G8_SA(1, 0), a3, 0, last);
            G8_BAR; G8_WAIT_L(0); G8_MMA(1, 0, At, B0); G8_BAR; G8_SCHED;
            G8_STAGE(G8_SB(1, 1), b3 + hstepB, voffB);
            G8_WAIT_V(6); G8_BAR; G8_MMA(1, 1, At, B1); G8_BAR;
        }
        if (P::FP8) asm volatile("s_nop 15\n\ts_nop 15" ::: "memory");
        prob.epi(acc, cur, wr, wc, fr, fq);
        if (!has_next) break;
#pragma unroll
        for (int a = 0; a < 2; ++a)
#pragma unroll
            for (int b = 0; b < 2; ++b)
#pragma unroll
                for (int m = 0; m < 4; ++m)
#pragma unroll
                    for (int n = 0; n < 2; ++n) acc[a][b][m][n] = (f32x4){0.f, 0.f, 0.f, 0.f};
        cur = nxt; cA = nA; cB = nB; ++ui;
        if (P::GATHER) {
#pragma unroll
            for (int h = 0; h < 2; ++h)
#pragma unroll
                for (int i = 0; i < 2; ++i) cvA[h][i] = nvA[h][i]; }
    }
    G8_WAIT_V(0);
    if (wr == 0) G8_BAR;
    G8_BAR;
#undef G8_SA
#undef G8_SB
#undef G8_STAGE
#undef G8_STAGE_SEL
#undef G8_LDA
#undef G8_LDB
#undef G8_MMA
#undef G8_WAIT_V
#undef G8_WAIT_L
#undef G8_BAR
#undef G8_SCHED
}
}

struct Args { const float* in[30]; float* out; unsigned char* ws; };
typedef const float* fptr_t;
typedef __attribute__((address_space(4))) const fptr_t* inarr_t;
struct Frame {
    LAS unsigned char* lds; unsigned char* ws; inarr_t in; float* out;
    int tid, lane, wave, G, vcu;
    DI const float* inp(int i) const { return (const float*)(const GBL float*)in[i]; }
};
DI Frame launder(const Frame& F0) {
    Frame F = F0;
    { unsigned long long x = (unsigned long long)F.ws; asm volatile("" : "+s"(x)); F.ws = (unsigned char*)(GBL unsigned char*)x; }
    { unsigned long long x = (unsigned long long)F.out; asm volatile("" : "+s"(x)); F.out = (float*)(GBL float*)x; }
    asm volatile("" : "+s"(F.in));
    asm volatile("" : "+v"(F.tid)); F.lane = F.tid & 63; F.wave = __builtin_amdgcn_readfirstlane(F.tid >> 6);
    asm volatile("" : "+s"(F.G)); asm volatile("" : "+s"(F.vcu));
    return F;
}
enum { I_X = 0, I_C, I_CTX, I_CCTX, I_WADA, I_BADA, I_LN1G, I_LN1B, I_LN2G, I_LN2B, I_LAMRE, I_LAMIM, I_LOGSTEP, I_BRE, I_BIM, I_CRE, I_CIM, I_S5D, I_WGLU,
       I_WIN, I_WA2, I_BA2, I_NORMG, I_WOUT, I_WROUTER, I_BROUTER, I_WUP, I_BUP, I_WDN, I_BDN };

DI const float* modp(const Frame& F, int layer, int b, int which) { return (const float*)(F.ws + WS_MOD) + ((size_t)(layer * 5 + b) * 6 + which) * 1024; }

struct ProbS5E {
    static constexpr bool GATHER = false;
    struct Unit { const char* a; const char* b; int g, rt; };
    const bf16_t* UP; const bf16_t* PIN; float* E; int G, vcu;
    static constexpr bool FP8 = false; DI int Kbytes() const { return 1024; } DI int ldaB() const { return 1536; } DI int ldbB() const { return 1024; }
    DI bool next(int i, Unit& u) const {
        const int L = i * G + vcu; if (L >= 64 * 5) return false;
        u.g = L / 5; u.rt = L % 5;
        u.a = (const char*)(UP + ((size_t)u.g * S5ROWS + u.rt * 256) * 768); u.b = (const char*)(PIN + (size_t)u.g * 256 * 512); return true; }
    DI void gather(const Unit&, int, unsigned (&)[2][2]) const {}
    DI void epi(const g8::Acc& acc, const Unit& u, int wr, int wc, int fr, int fq) const {
#pragma unroll
        for (int ai = 0; ai < 2; ++ai)
#pragma unroll
            for (int m = 0; m < 4; ++m) {
                const int row = u.rt * 256 + ai * 128 + wr * 64 + m * 16 + fr;
                float* rowp = E + ((size_t)u.g * S5ROWS + row) * 256 + wc * 32 + fq * 8;
#pragma unroll
                for (int bj = 0; bj < 2; ++bj) { *(f32x4*)(rowp + bj * 128) = acc[ai][bj][m][0]; *(f32x4*)(rowp + bj * 128 + 4) = acc[ai][bj][m][1]; }
            }
    }
};
struct ProbS5Y {
    static constexpr bool GATHER = false;
    struct Unit { const char* a; const char* b; int g, rt, pn; };
    const bf16_t* UP; const bf16_t* M; bf16_t* YG; int G, vcu;
    static constexpr bool FP8 = false; DI int Kbytes() const { return 1536; } DI int ldaB() const { return 1536; } DI int ldbB() const { return 1536; }
    DI bool next(int i, Unit& u) const {
        const int L = i * G + vcu; if (L >= 64 * 5 * 2) return false;
        u.pn = L & 1; u.rt = (L >> 1) % 5; u.g = L / 10;
        u.a = (const char*)(UP + ((size_t)u.g * S5ROWS + u.rt * 256) * 768); u.b = (const char*)(M + ((size_t)u.g * 512 + u.pn * 256) * 768); return true; }
    DI void gather(const Unit&, int, unsigned (&)[2][2]) const {}
    DI void epi(const g8::Acc& acc, const Unit& u, int wr, int wc, int fr, int fq) const {
#pragma unroll
        for (int ai = 0; ai < 2; ++ai)
#pragma unroll
            for (int m = 0; m < 4; ++m) {
                const int cr = u.rt * 256 + ai * 128 + wr * 64 + m * 16 + fr;
                if (cr < S5VALID) {
                    const int tokbase = cr < 1024 ? (cr >> 8) * SEQ + (cr & 255) * S5T : TL + (cr - 1024) * S5T;
#pragma unroll
                    for (int bj = 0; bj < 2; ++bj) {
                        const int c = u.pn * 256 + bj * 128 + wc * 32 + fq * 8;
                        const int t = c >> 4, h0 = c & 15;
                        const f32x4 v0 = acc[ai][bj][m][0], v1 = acc[ai][bj][m][1];
                        u32x4 o; o[0] = cvt_pk_bf16(gelu_tanh(v0[0]), gelu_tanh(v0[1])); o[1] = cvt_pk_bf16(gelu_tanh(v0[2]), gelu_tanh(v0[3]));
                        o[2] = cvt_pk_bf16(gelu_tanh(v1[0]), gelu_tanh(v1[1])); o[3] = cvt_pk_bf16(gelu_tanh(v1[2]), gelu_tanh(v1[3]));
                        *(u32x4*)(YG + (size_t)(tokbase + t) * D + u.g * 16 + h0) = o;
                    }
                }
            }
    }
};
struct ProbGLU {
    static constexpr bool GATHER = false;
    struct Unit { const char* a; const char* b; int rt, pn; };
    const bf16_t* A; const bf16_t* W; float* H; const float* mod_g1_base;   int G, vcu;
    static constexpr bool FP8 = false; DI int Kbytes() const { return 2048; } DI int ldaB() const { return 2048; } DI int ldbB() const { return 2048; }
    DI bool next(int i, Unit& u) const {
        const int L = i * G + vcu; if (L >= (TT / 256) * 8) return false;
        u.pn = L & 7; u.rt = L >> 3;
        u.a = (const char*)(A + (size_t)u.rt * 256 * 1024); u.b = (const char*)(W + (size_t)u.pn * 256 * 1024); return true; }
    DI void gather(const Unit&, int, unsigned (&)[2][2]) const {}
    DI void epi(const g8::Acc& acc, const Unit& u, int wr, int wc, int fr, int fq) const {
        const int row0 = u.rt * 256; const int b = row0 < TL ? (row0 >> 13) : 4;
        const int c = u.pn * 128 + wc * 32 + fq * 8;
        const float* g1p = mod_g1_base + (size_t)b * 6144 + 2 * 1024 + c;
        const f32x4 g1a = *(const f32x4*)g1p, g1b = *(const f32x4*)(g1p + 4);
#pragma unroll
        for (int ai = 0; ai < 2; ++ai)
#pragma unroll
            for (int m = 0; m < 4; ++m) {
                const int row = row0 + ai * 128 + wr * 64 + m * 16 + fr;
                float* hp = H + (size_t)row * D + c;
                f32x4 h0 = *(f32x4*)hp, h1 = *(f32x4*)(hp + 4);
                const f32x4 va = acc[ai][0][m][0], vb = acc[ai][0][m][1], ga = acc[ai][1][m][0], gb = acc[ai][1][m][1];
#pragma unroll
                for (int i = 0; i < 4; ++i) { h0[i] = DN_ALPHA * h0[i] + g1a[i] * (va[i] * sigmoidf_(ga[i])); h1[i] = DN_ALPHA * h1[i] + g1b[i] * (vb[i] * sigmoidf_(gb[i])); }
                *(f32x4*)hp = h0; *(f32x4*)(hp + 4) = h1;
            }
    }
};
struct ProbProj {
    static constexpr bool GATHER = false;
    struct Unit { const char* a; const char* b; int rt, pn; };
    const bf16_t* A; const bf16_t* W; bf16_t* P; int G, vcu;
    static constexpr bool FP8 = false; DI int Kbytes() const { return 2048; } DI int ldaB() const { return 2048; } DI int ldbB() const { return 2048; }
    DI bool next(int i, Unit& u) const {
        const int L = i * G + vcu; if (L >= (TT / 256) * 12) return false;
        u.pn = L % 12; u.rt = L / 12;
        u.a = (const char*)(A + (size_t)u.rt * 256 * 1024); u.b = (const char*)(W + (size_t)u.pn * 256 * 1024); return true; }
    DI void gather(const Unit&, int, unsigned (&)[2][2]) const {}
    DI void epi(const g8::Acc& acc, const Unit& u, int wr, int wc, int fr, int fq) const {
#pragma unroll
        for (int ai = 0; ai < 2; ++ai)
#pragma unroll
            for (int m = 0; m < 4; ++m) {
                const int row = u.rt * 256 + ai * 128 + wr * 64 + m * 16 + fr;
#pragma unroll
                for (int bj = 0; bj < 2; ++bj) {
                    const int c = u.pn * 256 + bj * 128 + wc * 32 + fq * 8;
                    const f32x4 v0 = acc[ai][bj][m][0], v1 = acc[ai][bj][m][1];
                    u32x4 o; o[0] = cvt_pk_bf16(v0[0], v0[1]); o[1] = cvt_pk_bf16(v0[2], v0[3]); o[2] = cvt_pk_bf16(v1[0], v1[1]); o[3] = cvt_pk_bf16(v1[2], v1[3]);
                    *(u32x4*)(P + (size_t)row * 3072 + c) = o;
                }
            }
    }
};
struct ProbOut {
    static constexpr bool GATHER = false;
    struct Unit { const char* a; const char* b; int rt, pn; };
    const bf16_t* A; const bf16_t* W; float* H; const float* mod_g1_base; int nrt; int G, vcu;
    static constexpr bool FP8 = false; DI int Kbytes() const { return 2048; } DI int ldaB() const { return 2048; } DI int ldbB() const { return 2048; }
    DI bool next(int i, Unit& u) const {
        const int L = i * G + vcu; if (L >= nrt * 4) return false;
        u.pn = L & 3; u.rt = L >> 2;
        u.a = (const char*)(A + (size_t)u.rt * 256 * 1024); u.b = (const char*)(W + (size_t)u.pn * 256 * 1024); return true; }
    DI void gather(const Unit&, int, unsigned (&)[2][2]) const {}
    DI void epi(const g8::Acc& acc, const Unit& u, int wr, int wc, int fr, int fq) const {
        const int row0 = u.rt * 256; const int b = row0 < TL ? (row0 >> 13) : 4;
#pragma unroll
        for (int ai = 0; ai < 2; ++ai)
#pragma unroll
            for (int m = 0; m < 4; ++m) {
                const int r = row0 + ai * 128 + wr * 64 + m * 16 + fr;
                int tok = r;
                if (r < TL) { const int np = r & 8191; tok = (r & ~8191) + (np & 127) * 64 + (np >> 7); }
#pragma unroll
                for (int bj = 0; bj < 2; ++bj) {
                    const int c = u.pn * 256 + bj * 128 + wc * 32 + fq * 8;
                    const float* g1p = mod_g1_base + (size_t)b * 6144 + 2 * 1024 + c;
                    const f32x4 g1a = *(const f32x4*)g1p, g1b = *(const f32x4*)(g1p + 4);
                    float* hp = H + (size_t)tok * D + c;
                    f32x4 h0 = *(f32x4*)hp, h1 = *(f32x4*)(hp + 4);
                    const f32x4 va = acc[ai][bj][m][0], vb = acc[ai][bj][m][1];
#pragma unroll
                    for (int i = 0; i < 4; ++i) { h0[i] = DN_ALPHA * h0[i] + g1a[i] * va[i]; h1[i] = DN_ALPHA * h1[i] + g1b[i] * vb[i]; }
                    *(f32x4*)hp = h0; *(f32x4*)(hp + 4) = h1;
                }
            }
    }
};
struct MoeTab { const LAS int* t; DI int cnt(int e) const { return t[e]; } DI int tpre(int e) const { return t[32 + e]; } };
struct ProbUp {
    static constexpr bool GATHER = true, FP8 = true;
    struct Unit { const char* a; const char* b; int e, rt, pn, cnt, prow; };
    const unsigned char* UB8; const unsigned char* W;   const float* bup;   const int* TOKL; unsigned char* ACT; MoeTab tab; int G, vcu;
    DI int Kbytes() const { return 1024; } DI int ldaB() const { return 1024; } DI int ldbB() const { return 1024; }
    DI bool next(int i, Unit& u) const {
        const int L = i * G + vcu; const int T = L >> 3;
        if (T >= tab.tpre(32)) return false;
        int e = 0;
#pragma unroll 1
        for (int q = 1; q < 32; ++q) e += (T >= tab.tpre(q)) ? 1 : 0;
        e = __builtin_amdgcn_readfirstlane(e);
        const int tp = __builtin_amdgcn_readfirstlane(tab.tpre(e));
        u.e = e; u.rt = T - tp; u.pn = L & 7; u.cnt = __builtin_amdgcn_readfirstlane(tab.cnt(e)); u.prow = (tp + u.rt) * 256;
        u.a = (const char*)UB8; u.b = (const char*)(W + ((size_t)e * 2048 + u.pn * 256) * 1024); return true; }
    DI void gather(const Unit& u, int tid, unsigned (&vo)[2][2]) const {
#pragma unroll
        for (int i = 0; i < 2; ++i) { int R, C; g8::stage_rc(tid * 16 + i * 8192, R, C);
#pragma unroll
            for (int h = 0; h < 2; ++h) { const int slot = u.rt * 256 + R + h * 128;
                const int tk = slot < u.cnt ? TOKL[(size_t)u.e * TT + slot] : 0;
                vo[h][i] = (unsigned)(tk >> 2) * 1024u + (unsigned)C * 2u; } }
    }
    DI void epi(const g8::Acc& acc, const Unit& u, int wr, int wc, int fr, int fq) const {
        const int c = u.pn * 128 + wc * 32 + fq * 8;
        const float* bp = bup + (size_t)u.e * 2048 + c;
        const f32x4 bga = *(const f32x4*)bp, bgb = *(const f32x4*)(bp + 4), bla = *(const f32x4*)(bp + 1024), blb = *(const f32x4*)(bp + 1028);
#pragma unroll
        for (int ai = 0; ai < 2; ++ai)
#pragma unroll
            for (int m = 0; m < 4; ++m) {
                const int r = ai * 128 + wr * 64 + m * 16 + fr;
                const f32x4 va = acc[ai][0][m][0] * 0.03125f + bga, vb = acc[ai][0][m][1] * 0.03125f + bgb, la = acc[ai][1][m][0] * 0.03125f + bla, lb = acc[ai][1][m][1] * 0.03125f + blb;
                float o[8];
#pragma unroll
                for (int i = 0; i < 4; ++i) {
                    const float g0 = fminf(va[i], 7.0f), l0 = fminf(fmaxf(la[i], -7.0f), 7.0f); o[i] = 4.0f * g0 * sigmoidf_(1.702f * g0) * (l0 + 1.0f);
                    const float g1 = fminf(vb[i], 7.0f), l1 = fminf(fmaxf(lb[i], -7.0f), 7.0f); o[4 + i] = 4.0f * g1 * sigmoidf_(1.702f * g1) * (l1 + 1.0f); }
                u32x2 ov; ov[0] = pack_fp8x4(o[0], o[1], o[2], o[3]); ov[1] = pack_fp8x4(o[4], o[5], o[6], o[7]);
                *(u32x2*)(ACT + (size_t)(u.prow + r) * D + c) = ov;
            }
    }
};
struct ProbDown {
    static constexpr bool GATHER = false, FP8 = true;
    struct Unit { const char* a; const char* b; int e, rt, pn, cnt; };
    const unsigned char* ACT; const unsigned char* W; const float* bdn;   const int* TOKL; const float* GATEL; bf16_t* FEXP; MoeTab tab; int G, vcu;
    DI int Kbytes() const { return 1024; } DI int ldaB() const { return 1024; } DI int ldbB() const { return 1024; }
    DI bool next(int i, Unit& u) const {
        const int L = i * G + vcu; const int T = L >> 2;
        if (T >= tab.tpre(32)) return false;
        int e = 0;
#pragma unroll 1
        for (int q = 1; q < 32; ++q) e += (T >= tab.tpre(q)) ? 1 : 0;
        e = __builtin_amdgcn_readfirstlane(e);
        const int tp = __builtin_amdgcn_readfirstlane(tab.tpre(e));
        u.e = e; u.rt = T - tp; u.pn = L & 3; u.cnt = __builtin_amdgcn_readfirstlane(tab.cnt(e));
        u.a = (const char*)(ACT + (size_t)(tp + u.rt) * 256 * D); u.b = (const char*)(W + ((size_t)e * 1024 + u.pn * 256) * 1024); return true; }
    DI void gather(const Unit&, int, unsigned (&)[2][2]) const {}
    DI void epi(const g8::Acc& acc, const Unit& u, int wr, int wc, int fr, int fq) const {
#pragma unroll
        for (int ai = 0; ai < 2; ++ai)
#pragma unroll
            for (int m = 0; m < 4; ++m) {
                const int slot = u.rt * 256 + ai * 128 + wr * 64 + m * 16 + fr;
                if (slot < u.cnt) {
                    const int tk = TOKL[(size_t)u.e * TT + slot]; const float gt = GATEL[(size_t)u.e * TT + slot];
#pragma unroll
                    for (int bj = 0; bj < 2; ++bj) {
                        const int c = u.pn * 256 + bj * 128 + wc * 32 + fq * 8;
                        const float* bp = bdn + (size_t)u.e * 1024 + c;
                        const f32x4 ba = *(const f32x4*)bp, bb = *(const f32x4*)(bp + 4);
                        const f32x4 va = (acc[ai][bj][m][0] * 0.00390625f + ba) * gt, vb = (acc[ai][bj][m][1] * 0.00390625f + bb) * gt;
                        u32x4 o; o[0] = cvt_pk_bf16(va[0], va[1]); o[1] = cvt_pk_bf16(va[2], va[3]); o[2] = cvt_pk_bf16(vb[0], vb[1]); o[3] = cvt_pk_bf16(vb[2], vb[3]);
                        *(u32x4*)(FEXP + (size_t)tk * D + c) = o;
                    }
                }
            }
    }
};
enum { IN_INIT = 0, IN_LN = 1, IN_COMBINE = 2 };
enum { OUT_S5 = 0, OUT_CMLR = 1, OUT_ROUTER = 2, OUT_FINAL = 3 };
constexpr int RP_TSTR = 2064;
constexpr int RP_TILE = 0;
constexpr int RP_RED = 66048;
constexpr int RP_LOGIT = RP_RED + 33792;
constexpr int RP_ENT_TK = RP_LOGIT + 4224;
constexpr int RP_ENT_GATE = RP_ENT_TK + 8192;
constexpr int RP_ENT_ER = RP_ENT_GATE + 8192;
constexpr int RP_HIST = RP_ENT_ER + 8192;
constexpr int RP_BASE = RP_HIST + 128;
static_assert(RP_BASE + 128 <= LDS_MISC, "row-pass LDS map");

DI int cm_row(int row) { if (row < TL) { const int l = row & 8191; return (row & ~8191) + (l & 63) * 128 + (l >> 6); } return row; }

template <int INM, int OUTM>
DI void row_pass(const Frame& F, int nrows, int mod_layer_in  , const float* ln_g, const float* ln_b,
                 int mod_layer_out, int mod_sh  , const bf16_t* Wt  , const float* wbias  ,
                 int moe_layer) {
    float* H = (float*)(F.ws + WS_H);
    bf16_t* UB = (bf16_t*)(F.ws + WS_UB);
    bf16_t* UP = (bf16_t*)(F.ws + WS_UP);
    unsigned char* UB8 = F.ws + WS_UB8;
    const bf16_t* FEXP = (const bf16_t*)(F.ws + WS_FEXP);
    float* ALR = (float*)(F.ws + WS_ALR);
    LAS unsigned char* lds = F.lds;
    LAS int* hist = (LAS int*)(lds + RP_HIST);
    LAS int* basev = (LAS int*)(lds + RP_BASE);
    LAS int* ent_tk = (LAS int*)(lds + RP_ENT_TK); LAS float* ent_gate = (LAS float*)(lds + RP_ENT_GATE); LAS int* ent_er = (LAS int*)(lds + RP_ENT_ER);
    const int lane = F.lane, w = F.wave, tid = F.tid;
    if (OUTM == OUT_ROUTER) { if (tid < 32) hist[tid] = 0; }
    __syncthreads();
    const int ntiles = nrows / 32;
    int titer = 0;
    for (int tt = F.vcu; tt < ntiles; tt += F.G, ++titer) {
        const int row0 = tt * 32;
        const int b = row0 < TL ? (row0 >> 13) : 4;
        f32x4 lg[4], lb[4], msc[4], msh[4], mg2[4];
#pragma unroll
        for (int i = 0; i < 4; ++i) {
            const int c = 256 * i + 4 * lane;
            if (INM != IN_INIT) { lg[i] = *(const f32x4*)(ln_g + c); lb[i] = *(const f32x4*)(ln_b + c); }
            if (INM == IN_COMBINE) mg2[i] = *(const f32x4*)(modp(F, mod_layer_in, b, 5) + c);
            if (OUTM != OUT_FINAL) { msh[i] = *(const f32x4*)(modp(F, mod_layer_out, b, mod_sh) + c); msc[i] = *(const f32x4*)(modp(F, mod_layer_out, b, mod_sh + 1) + c); }
        }
#pragma unroll 1
        for (int rr = 0; rr < 4; ++rr) {
            const int rl = 4 * w + rr, row = row0 + rl;
            f32x4 v[4];
            if (INM == IN_INIT) {
                const float* src = row < TL ? F.inp(I_X) + (size_t)row * D : F.inp(I_CTX) + (size_t)(row - TL) * D;
#pragma unroll
                for (int i = 0; i < 4; ++i) v[i] = *(const f32x4*)(src + 256 * i + 4 * lane);
            } else {
#pragma unroll
                for (int i = 0; i < 4; ++i) v[i] = *(const f32x4*)(H + (size_t)row * D + 256 * i + 4 * lane);
            }
            if (INM == IN_COMBINE) {
#pragma unroll
                for (int i = 0; i < 4; ++i) {
                    f32x4 f = (f32x4){0.f, 0.f, 0.f, 0.f};
#pragma unroll
                    for (int k = 0; k < 4; ++k) {
                        const u32x2 p = *(const u32x2*)(FEXP + ((size_t)row * 4 + k) * D + 256 * i + 4 * lane);
                        f[0] += bf_lo(p[0]); f[1] += bf_hi(p[0]); f[2] += bf_lo(p[1]); f[3] += bf_hi(p[1]);
                    }
                    v[i] = DN_ALPHA * v[i] + mg2[i] * f;
                }
            }
            if (INM != IN_INIT) {
                float s = 0.f;
#pragma unroll
                for (int i = 0; i < 4; ++i) s += v[i][0] + v[i][1] + v[i][2] + v[i][3];
                const float mean = wave_sum(s) * (1.0f / 1024.0f);
                float q = 0.f;
#pragma unroll
                for (int i = 0; i < 4; ++i) { v[i] = v[i] - mean; q += v[i][0] * v[i][0] + v[i][1] * v[i][1] + v[i][2] * v[i][2] + v[i][3] * v[i][3]; }
                const float rstd = rsqrtf(wave_sum(q) * (1.0f / 1024.0f) + LN_EPS);
#pragma unroll
                for (int i = 0; i < 4; ++i) v[i] = v[i] * rstd * lg[i] + lb[i];
            }
            if (OUTM == OUT_FINAL) {
#pragma unroll
                for (int i = 0; i < 4; ++i) *(f32x4*)(F.out + (size_t)row * D + 256 * i + 4 * lane) = v[i];
            } else {
#pragma unroll
                for (int i = 0; i < 4; ++i) *(f32x4*)(H + (size_t)row * D + 256 * i + 4 * lane) = v[i];
                const int drow = (OUTM == OUT_CMLR) ? cm_row(row) : row;
#pragma unroll
                for (int i = 0; i < 4; ++i) {
                    const f32x4 u = v[i] * (msc[i] + 1.0f) + msh[i];
                    u32x2 p; p[0] = cvt_pk_bf16(u[0], u[1]); p[1] = cvt_pk_bf16(u[2], u[3]);
                    *(LAS u32x2*)(lds + RP_TILE + rl * RP_TSTR + (256 * i + 4 * lane) * 2) = p;
                    if (OUTM == OUT_CMLR) *(u32x2*)(UB + (size_t)drow * D + 256 * i + 4 * lane) = p;
                    if (OUTM == OUT_ROUTER) *(unsigned*)(UB8 + (size_t)drow * D + 256 * i + 4 * lane) = pack_fp8x4(u[0], u[1], u[2], u[3]);
                }
            }
        }
        if (OUTM == OUT_FINAL) continue;
        __syncthreads();
        if (OUTM == OUT_S5) {
            const int t = lane >> 1, half = lane & 1;
#pragma unroll
            for (int gg = 0; gg < 8; ++gg) {
                const int g = w * 8 + gg;
                const u32x4 p = *(const LAS u32x4*)(lds + RP_TILE + t * RP_TSTR + (g * 16 + half * 8) * 2);
                *(u32x4*)(UP + ((size_t)g * S5ROWS + tt) * 768 + t * 16 + half * 8) = p;
            }
        } else {
            f32x16 acc;
#pragma unroll
            for (int i = 0; i < 16; ++i) acc[i] = 0.f;
            const int r = lane & 31, hh = lane >> 5;
#pragma unroll
            for (int s = 0; s < 8; ++s) {
                const int k0 = 128 * w + 16 * s + 8 * hh;
                const bf16x8 a = *(const LAS bf16x8*)(lds + RP_TILE + r * RP_TSTR + k0 * 2);
                const bf16x8 bb = *(const bf16x8*)(Wt + (size_t)r * D + k0);
                acc = __builtin_amdgcn_mfma_f32_32x32x16_bf16(a, bb, acc, 0, 0, 0);
            }
            LAS float* red = (LAS float*)(lds + RP_RED) + w * (32 * 33);
#pragma unroll
            for (int i = 0; i < 16; ++i) { const int xr = (i & 3) + 8 * (i >> 2) + 4 * hh; red[xr * 33 + r] = acc[i]; }
            __syncthreads();
            LAS float* logit = (LAS float*)(lds + RP_LOGIT);
#pragma unroll
            for (int q = 0; q < 2; ++q) {
                const int idx = tid + 512 * q, xr = idx >> 5, xc = idx & 31;
                float s = wbias ? wbias[xc] : 0.f;
#pragma unroll
                for (int ww = 0; ww < 8; ++ww) s += ((LAS float*)(lds + RP_RED))[ww * (32 * 33) + xr * 33 + xc];
                if (OUTM == OUT_CMLR) ALR[(size_t)cm_row(row0 + xr) * 32 + xc] = s;
                else logit[xr * 33 + xc] = s;
            }
            if (OUTM == OUT_ROUTER) {
                __syncthreads();
                if (tid < 32) {
                    float lv[32];
#pragma unroll
                    for (int e = 0; e < 32; ++e) lv[e] = logit[tid * 33 + e];
                    unsigned taken = 0u; float tv[4]; int ti[4];
#pragma unroll
                    for (int k = 0; k < 4; ++k) {
                        float best = -3.0e38f; int bi = 0;
#pragma unroll
                        for (int e = 0; e < 32; ++e) { const bool ok = !((taken >> e) & 1u) && (lv[e] > best); best = ok ? lv[e] : best; bi = ok ? e : bi; }
                        taken |= 1u << bi; tv[k] = best; ti[k] = bi;
                    }
                    float ex[4], se = 0.f;
#pragma unroll
                    for (int k = 0; k < 4; ++k) { ex[k] = __expf(tv[k] - tv[0]); se += ex[k]; }
                    const float inv = 1.0f / se;
#pragma unroll
                    for (int k = 0; k < 4; ++k) {
                        const int rank = __hip_atomic_fetch_add(&hist[ti[k]], 1, __ATOMIC_RELAXED, __HIP_MEMORY_SCOPE_WORKGROUP);
                        const int n = titer * 128 + tid * 4 + k;
                        ent_tk[n] = (row0 + tid) * 4 + k; ent_gate[n] = ex[k] * inv; ent_er[n] = (ti[k] << 16) | rank;
                    }
                }
            }
        }
        __syncthreads();
    }
    if (OUTM == OUT_ROUTER) {
        __syncthreads();
        unsigned* CNT = (unsigned*)(F.ws + WS_CTL) + CW_CNT + moe_layer * 32;
        if (tid < 32) basev[tid] = (int)__hip_atomic_fetch_add(&CNT[tid], (unsigned)hist[tid], __ATOMIC_RELAXED, __HIP_MEMORY_SCOPE_AGENT);
        __syncthreads();
        int* TOKL = (int*)(F.ws + WS_TOKL); float* GATEL = (float*)(F.ws + WS_GATEL);
        const int nent = titer * 128;
        for (int n = tid; n < nent; n += NTHR) {
            const int er = ent_er[n], e = er >> 16, slot = basev[e] + (er & 0xffff);
            TOKL[(size_t)e * TT + slot] = ent_tk[n]; GATEL[(size_t)e * TT + slot] = ent_gate[n];
        }
    }
}

constexpr int PC_A = 0;
constexpr int PC_BB = 33792;
constexpr int PC_C = PC_BB + 16384;
constexpr int PC_K = PC_C + 16384;
static_assert(PC_K + 65536 <= LDS_MISC, "precompute LDS map");
typedef float cf __attribute__((ext_vector_type(2)));
DI cf mkcf(float x, float y) { cf r; r.x = x; r.y = y; return r; }
DI cf cmul(cf a, cf b) { return mkcf(a.x * b.x - a.y * b.y, a.x * b.y + a.y * b.x); }

DI void s5_precompute(const Frame& F, int j, int g) {
    LAS cf* PA = (LAS cf*)(F.lds + PC_A); LAS cf* PB = (LAS cf*)(F.lds + PC_BB); LAS cf* PCc = (LAS cf*)(F.lds + PC_C); LAS float* PK = (LAS float*)(F.lds + PC_K);
    const int tid = F.tid;
    __syncthreads();
    if (tid < 128) {
        const int dir = tid >> 6, p = tid & 63;
        const size_t gp = ((size_t)(j * 2 + dir) * 64 + g) * 64 + p;
        const float lr = F.inp(I_LAMRE)[gp], li = F.inp(I_LAMIM)[gp];
        const float dt = expf(F.inp(I_LOGSTEP)[(size_t)(j * 2 + dir) * 64 + g]);
        const float mag = expf(lr * dt); float sn, cs; sincosf(li * dt, &sn, &cs);
        const cf a = mkcf(mag * cs, mag * sn);
        const float den = lr * lr + li * li; const float nr = a.x - 1.0f;
        const cf kf = mkcf((nr * lr + a.y * li) / den, (a.y * lr - nr * li) / den);
        cf pw = mkcf(1.0f, 0.0f);
        for (int n = 0; n <= 32; ++n) { PA[(dir * 33 + n) * 64 + p] = pw; pw = cmul(pw, a); }
        for (int h = 0; h < 16; ++h) { const cf bb = mkcf(F.inp(I_BRE)[gp * 16 + h], F.inp(I_BIM)[gp * 16 + h]); PB[(dir * 64 + p) * 16 + h] = cmul(kf, bb); }
        for (int h = 0; h < 16; ++h) { const size_t ci = (((size_t)(j * 2 + dir) * 64 + g) * 16 + h) * 64 + p; PCc[(dir * 16 + h) * 64 + p] = mkcf(F.inp(I_CRE)[ci], F.inp(I_CIM)[ci]); }
    }
    __syncthreads();
    for (int idx = tid; idx < 2 * 32 * 256; idx += NTHR) {
        const int h = idx & 15, hp = (idx >> 4) & 15, tau = (idx >> 8) & 31, dir = idx >> 13;
        float s = 0.f;
        for (int p = 0; p < 64; ++p) { const cf c = PCc[(dir * 16 + hp) * 64 + p], a = PA[(dir * 33 + tau) * 64 + p], bb = PB[(dir * 64 + p) * 16 + h]; const cf ca = cmul(c, a); s += ca.x * bb.x - ca.y * bb.y; }
        PK[idx] = s;
    }
    __syncthreads();
    bf16_t* M = (bf16_t*)(F.ws + WS_S5M) + (size_t)(j * 64 + g) * 512 * 768;
    const float* dsk = F.inp(I_S5D) + (size_t)j * D + g * 16;
    for (int idx = tid; idx < 512 * 768; idx += NTHR) {
        const int rho = idx / 768, kc = idx % 768;
        const int o = (rho & ~31) + perm32(rho & 31);
        const int t = o >> 4, hp = o & 15;
        float val;
        if (kc < 512) {
            const int jj = kc >> 4, h = kc & 15;
            val = 0.f;
            if (jj <= t) val += PK[((0 * 32 + (t - jj)) * 16 + hp) * 16 + h];
            if (jj >= t) val += PK[((1 * 32 + (jj - t)) * 16 + hp) * 16 + h];
            if (jj == t && h == hp) val += dsk[hp];
        } else {
            const int s = kc - 512, dir = s >> 7, im = (s >> 6) & 1, p = s & 63;
            const int n = dir == 0 ? t + 1 : 32 - t;
            const cf z = cmul(PCc[(dir * 16 + hp) * 64 + p], PA[(dir * 33 + n) * 64 + p]);
            val = im ? -z.y : z.x;
        }
        M[idx] = f2bf(val);
    }
    bf16_t* PIN = (bf16_t*)(F.ws + WS_S5PIN) + (size_t)(j * 64 + g) * 256 * 512;
    for (int idx = tid; idx < 256 * 512; idx += NTHR) {
        const int rho = idx >> 9, kc = idx & 511;
        const int s = (rho & ~31) + perm32(rho & 31);
        const int dir = s >> 7, im = (s >> 6) & 1, p = s & 63;
        const int jj = kc >> 4, h = kc & 15;
        const int n = dir == 0 ? 31 - jj : jj;
        const cf x = cmul(PA[(dir * 33 + n) * 64 + p], PB[(dir * 64 + p) * 16 + h]);
        PIN[idx] = f2bf(im ? x.y : x.x);
    }
    if (tid < 128) { const int dir = tid >> 6, p = tid & 63; const cf aT = PA[(dir * 33 + 32) * 64 + p];
        float* AT = (float*)(F.ws + WS_S5AT) + (((size_t)(j * 64 + g) * 2 + dir) * 64 + p) * 2; AT[0] = aT.x; AT[1] = aT.y; }
}

DI void mod_item(const Frame& F, int layer, int nblk) {
    LAS float* cond = (LAS float*)(F.lds);
    LAS float* red = (LAS float*)(F.lds + 20480);
    const int tid = F.tid;
    __syncthreads();
    for (int idx = tid; idx < 5 * 1024; idx += NTHR) { const int r = idx >> 10, k = idx & 1023; const float c = r < 4 ? F.inp(I_C)[r * 1024 + k] : F.inp(I_CCTX)[k]; cond[idx] = c / (1.0f + __expf(-c)); }
    __syncthreads();
    const int cq = tid & 31, kg = tid >> 5, n0 = nblk * 128;
    const float* W = F.inp(I_WADA) + (size_t)layer * 1024 * 6144 + n0 + cq * 4;
    f32x4 acc[5];
#pragma unroll
    for (int r = 0; r < 5; ++r) acc[r] = (f32x4){0.f, 0.f, 0.f, 0.f};
#pragma unroll 8
    for (int kk = 0; kk < 64; ++kk) {
        const int k = kg * 64 + kk;
        const f32x4 wv = *(const f32x4*)(W + (size_t)k * 6144);
#pragma unroll
        for (int r = 0; r < 5; ++r) acc[r] += cond[r * 1024 + k] * wv;
    }
#pragma unroll
    for (int r = 0; r < 5; ++r)
#pragma unroll
        for (int i = 0; i < 4; ++i) red[(kg * 5 + r) * 128 + cq * 4 + i] = acc[r][i];
    __syncthreads();
    for (int idx = tid; idx < 5 * 128; idx += NTHR) {
        const int r = idx >> 7, n = idx & 127;
        float s = F.inp(I_BADA)[(size_t)layer * 6144 + n0 + n];
        for (int q = 0; q < 16; ++q) s += red[(q * 5 + r) * 128 + n];
        ((float*)(F.ws + WS_MOD))[(size_t)(layer * 5 + r) * 6144 + n0 + n] = s;
    }
}

DI int phys_row(int n, int mode) {
    if (mode == 0) return (n & ~31) + inv32(n & 31);
    const int half = n >> 10, jn = n & 1023;
    return 256 * (jn >> 7) + 128 * half + 32 * ((jn & 127) >> 5) + inv32(jn & 31);
}
DI void transpose_tile(const Frame& F, const float* src, int ld, bf16_t* dst, int mode, int kt, int ntile) {
    LAS bf16_t* T = (LAS bf16_t*)F.lds;
    const int tid = F.tid, k0 = kt * 128, n0 = ntile * 128;
    __syncthreads();
#pragma unroll
    for (int q = 0; q < 8; ++q) {
        const int idx = tid + 512 * q, kr = idx >> 5, c4 = idx & 31;
        const f32x4 v = *(const f32x4*)(src + (size_t)(k0 + kr) * ld + n0 + c4 * 4);
#pragma unroll
        for (int i = 0; i < 4; ++i) T[(c4 * 4 + i) * 136 + kr] = f2bf(v[i]);
    }
    __syncthreads();
#pragma unroll
    for (int q = 0; q < 4; ++q) {
        const int idx = tid + 512 * q, nl = idx >> 4, ch = idx & 15;
        const u32x4 p = *(const LAS u32x4*)(T + nl * 136 + ch * 8);
        *(u32x4*)(dst + (size_t)phys_row(n0 + nl, mode) * 1024 + k0 + ch * 8) = p;
    }
}
DI void transpose_tile8(const Frame& F, const float* src, int ld, unsigned char* dst, int mode, int kt, int ntile, float scale) {
    LAS unsigned char* T = F.lds;
    const int tid = F.tid, k0 = kt * 128, n0 = ntile * 128;
    __syncthreads();
#pragma unroll
    for (int q = 0; q < 2; ++q) {
        const int task = tid + 512 * q, k4 = task >> 5, c4 = task & 31;
        f32x4 v[4];
#pragma unroll
        for (int r = 0; r < 4; ++r) v[r] = *(const f32x4*)(src + (size_t)(k0 + k4 * 4 + r) * ld + n0 + c4 * 4) * scale;
#pragma unroll
        for (int i = 0; i < 4; ++i) *(LAS unsigned*)(T + (c4 * 4 + i) * 144 + k4 * 4) = pack_fp8x4(v[0][i], v[1][i], v[2][i], v[3][i]);
    }
    __syncthreads();
#pragma unroll
    for (int q = 0; q < 2; ++q) {
        const int idx = tid + 512 * q, nl = idx >> 3, ch = idx & 7;
        const u32x4 p = *(const LAS u32x4*)(T + nl * 144 + ch * 16);
        *(u32x4*)(dst + (size_t)phys_row(n0 + nl, mode) * 1024 + k0 + ch * 16) = p;
    }
}
DI void small_transpose(const Frame& F, const float* src, int ld, int c0, bf16_t* dst) {
    for (int idx = F.tid; idx < 32 * 1024; idx += NTHR) { const int e = idx >> 10, k = idx & 1023; dst[idx] = f2bf(src[(size_t)k * ld + c0 + e]); }
}

constexpr int PI_S5 = 128, PI_MOD = 192, PI_GLU = 2 * 128, PI_WIN = 2 * 192, PI_WOUT = 2 * 64, PI_UP = 128 * 128, PI_DN = 128 * 64, PI_SMALL = 6;
constexpr int PI_TOTAL = PI_S5 + PI_MOD + PI_GLU + PI_WIN + PI_WOUT + PI_UP + PI_DN + PI_SMALL;
DI void prologue_item(const Frame& F, int it) {
    if (it < PI_S5) { s5_precompute(F, it >> 6, it & 63); return; } it -= PI_S5;
    if (it < PI_MOD) { mod_item(F, it / 48, it % 48); return; } it -= PI_MOD;
    if (it < PI_GLU) { const int j = it >> 7, r = it & 127;
        transpose_tile(F, F.inp(I_WGLU) + (size_t)j * 1024 * 2048, 2048, (bf16_t*)(F.ws + WS_WGLU) + (size_t)j * 2048 * 1024, 1, r & 7, r >> 3); return; } it -= PI_GLU;
    if (it < PI_WIN) { const int j = it / 192, r = it % 192;
        transpose_tile(F, F.inp(I_WIN) + (size_t)j * 1024 * 3104, 3104, (bf16_t*)(F.ws + WS_WIN) + (size_t)j * 3072 * 1024, 0, r & 7, r >> 3); return; } it -= PI_WIN;
    if (it < PI_WOUT) { const int j = it >> 6, r = it & 63;
        transpose_tile(F, F.inp(I_WOUT) + (size_t)j * 1024 * 1024, 1024, (bf16_t*)(F.ws + WS_WOUT) + (size_t)j * 1024 * 1024, 0, r & 7, r >> 3); return; } it -= PI_WOUT;
    if (it < PI_UP) { const int le = it >> 7, r = it & 127;
        transpose_tile8(F, F.inp(I_WUP) + (size_t)le * 1024 * 2048, 2048, F.ws + WS_WUP + (size_t)le * 2048 * 1024, 1, r & 7, r >> 3, 32.0f); return; } it -= PI_UP;
    if (it < PI_DN) { const int le = it >> 6, r = it & 63;
        transpose_tile8(F, F.inp(I_WDN) + (size_t)le * 1024 * 1024, 1024, F.ws + WS_WDN + (size_t)le * 1024 * 1024, 0, r & 7, r >> 3, 64.0f); return; } it -= PI_DN;
    if (it < 4) { small_transpose(F, F.inp(I_WROUTER) + (size_t)it * 1024 * 32, 32, 0, (bf16_t*)(F.ws + WS_WR) + (size_t)it * 32 * 1024); return; }
    it -= 4;
    small_transpose(F, F.inp(I_WIN) + (size_t)it * 1024 * 3104, 3104, 3072, (bf16_t*)(F.ws + WS_WLR) + (size_t)it * 32 * 1024);
}

DI void s5_scan(const Frame& F, int j) {
    const float* E = (const float*)(F.ws + WS_E);
    bf16_t* UP = (bf16_t*)(F.ws + WS_UP);
    const float* AT = (const float*)(F.ws + WS_S5AT);
    const int sub = F.tid >> 7, t7 = F.tid & 127, dir = t7 >> 6, p = t7 & 63;
    for (int item = F.vcu + F.G * sub; item < 256; item += 4 * F.G) {
        const int b = item >> 6, g = item & 63;
        const float* at = AT + (((size_t)(j * 64 + g) * 2 + dir) * 64 + p) * 2;
        const float ar = at[0], ai = at[1];
        const float* Eg = E + (size_t)g * S5ROWS * 256 + dir * 128 + p;
        bf16_t* Ug = UP + (size_t)g * S5ROWS * 768 + 512 + dir * 128 + p;
        float sr = 0.f, si = 0.f;
#pragma unroll 1
        for (int blk = 0; blk < 33; ++blk) {
            float er[8], ei[8]; int crs[8];
#pragma unroll
            for (int q = 0; q < 8; ++q) {
                const int s = blk * 8 + q;
                int cr;
                if (s < 8) cr = 1024 + b * 8 + (dir == 0 ? s : 7 - s);
                else cr = b * 256 + (dir == 0 ? (s - 8) : 255 - (s - 8));
                crs[q] = cr;
                er[q] = Eg[(size_t)cr * 256]; ei[q] = Eg[(size_t)cr * 256 + 64];
            }
#pragma unroll
            for (int q = 0; q < 8; ++q) {
                Ug[(size_t)crs[q] * 768] = f2bf(sr); Ug[(size_t)crs[q] * 768 + 64] = f2bf(si);
                const float nr = ar * sr - ai * si + er[q], ni = ar * si + ai * sr + ei[q];
                sr = nr; si = ni;
            }
        }
    }
}

DI bf16_t* qke_ptr(const Frame& F, int dir, int which) { return (bf16_t*)(F.ws + WS_QKE) + (size_t)(dir * 3 + which) * TT * 512; }
DI void gla_gates(const Frame& F, int j) {
    LAS float* as = (LAS float*)F.lds;
    const bf16_t* P = (const bf16_t*)(F.ws + WS_P);
    const float* ALR = (const float*)(F.ws + WS_ALR);
    float* GCH = (float*)(F.ws + WS_GCH);
    const int c = F.tid;
    for (int it = F.vcu; it < 528 * 2; it += F.G) {
        const int cg = it >> 1, dir = it & 1, row0 = cg * 64;
        __syncthreads();
        for (int idx = F.tid; idx < 1024; idx += NTHR) { const int t = idx >> 4, r = idx & 15; as[idx] = ALR[(size_t)(row0 + t) * 32 + dir * 16 + r]; }
        __syncthreads();
        float w[16];
#pragma unroll
        for (int r = 0; r < 16; ++r) w[r] = F.inp(I_WA2)[((size_t)(j * 2 + dir) * 16 + r) * 512 + c];
        const float bias = F.inp(I_BA2)[(size_t)(j * 2 + dir) * 512 + c];
        float la[64]; float tot = 0.f;
#pragma unroll
        for (int t = 0; t < 64; ++t) {
            float x = bias;
#pragma unroll
            for (int r4 = 0; r4 < 4; ++r4) { const f32x4 a = *(const LAS f32x4*)(as + t * 16 + r4 * 4); x += a[0] * w[r4 * 4] + a[1] * w[r4 * 4 + 1] + a[2] * w[r4 * 4 + 2] + a[3] * w[r4 * 4 + 3]; }
            la[t] = (fminf(x, 0.f) - __logf(1.0f + __expf(-fabsf(x)))) * (1.0f / 16.0f);
            tot += la[t];
        }
        bf16_t* QD = qke_ptr(F, dir, 0); bf16_t* KD = qke_ptr(F, dir, 1); bf16_t* KE = qke_ptr(F, dir, 2);
        float pre = 0.f;
#pragma unroll
        for (int tb = 0; tb < 4; ++tb) {
            bf16_t qv[16], kv[16];
#pragma unroll
            for (int u = 0; u < 16; ++u) { const size_t row = (size_t)(row0 + tb * 16 + u); qv[u] = P[row * 3072 + c]; kv[u] = P[row * 3072 + 512 + c]; }
#pragma unroll
            for (int u = 0; u < 16; ++u) {
                const int t = tb * 16 + u;
                pre += la[t];
                const float bq = dir == 0 ? pre : (tot - pre + la[t]);
                const float ee = tot - bq;
                const size_t row = (size_t)(row0 + t);
                const float q = bf2f(qv[u]), k = bf2f(kv[u]);
                QD[row * 512 + c] = f2bf(q * 0.08838834764831845f * __expf(bq));
                KD[row * 512 + c] = f2bf(k * __expf(-bq));
                KE[row * 512 + c] = f2bf(k * __expf(ee));
            }
        }
        GCH[((size_t)cg * 2 + dir) * 512 + c] = __expf(tot);
    }
}

constexpr int GC_XSTR = 272, GC_VSTR = 80, GC_ASTR = 144;
constexpr int GC_QD = 0, GC_KD = 64 * GC_XSTR, GC_KE = 2 * 64 * GC_XSTR, GC_V = 3 * 64 * GC_XSTR, GC_BUF = 3 * 64 * GC_XSTR + 64 * GC_VSTR;
constexpr int GC_ATT = 2 * GC_BUF, GC_S = GC_ATT + 64 * GC_ASTR;
static_assert(GC_S + 128 * GC_VSTR <= LDS_MISC, "gla chunk LDS map");
DI bf16x8 tr_frag(const LAS unsigned char* base, int stride, int k0, int c0, int lane) {
    const int q = (lane & 15) >> 2, p = lane & 3, quad = lane >> 4;
    const LAS unsigned char* a = base + (k0 + quad * 8 + q) * stride + (c0 + 4 * p) * 2;
    const s16x4 lo = __builtin_amdgcn_ds_read_tr16_b64_v4i16((LAS s16x4*)a);
    const s16x4 hi = __builtin_amdgcn_ds_read_tr16_b64_v4i16((LAS s16x4*)(a + 4 * stride));
    return __builtin_shufflevector(lo, hi, 0, 1, 2, 3, 4, 5, 6, 7);
}
DI void gla_chunks(const Frame& F) {
    LAS unsigned char* lds = F.lds;
    const bf16_t* P = (const bf16_t*)(F.ws + WS_P);
    const float* GCH = (const float*)(F.ws + WS_GCH);
    const int tid = F.tid, lane = F.lane, w = F.wave, fr = lane & 15, quad = lane >> 4;
    for (int item = F.vcu; item < 256; item += F.G) {
        const int sl = item & 7, dir = (item >> 3) & 1, hd = (item >> 4) & 3, b = item >> 6;
        const bf16_t* QD = qke_ptr(F, dir, 0); const bf16_t* KD = qke_ptr(F, dir, 1); const bf16_t* KE = qke_ptr(F, dir, 2);
        bf16_t* O = (bf16_t*)(F.ws + WS_O) + (size_t)dir * TT * D;
        __syncthreads();
        for (int idx = tid; idx < 128 * GC_VSTR / 4; idx += NTHR) ((LAS unsigned*)(lds + GC_S))[idx] = 0u;
        f32x4 sacc[2]; sacc[0] = (f32x4){0.f, 0.f, 0.f, 0.f}; sacc[1] = sacc[0];
        u32x4 pq[2], pk[2], pe[2], pv;
        const int xr0 = tid >> 4, xc = tid & 15;
        const int vr = (tid & 255) >> 2, vc = tid & 3;
#define rowbase_of(s) ((s) < 4 ? TL + b * LCTX + (dir == 0 ? (s) : 3 - (s)) * 64 : b * SEQ + (dir == 0 ? ((s) - 4) : 127 - ((s) - 4)) * 64)
#define GC_LOAD(s) do { const int _rb = rowbase_of(s); \
        _Pragma("unroll") for (int _i = 0; _i < 2; ++_i) { const size_t _o = (size_t)(_rb + xr0 + 32 * _i) * 512 + hd * 128 + xc * 8; \
            pq[_i] = *(const u32x4*)(QD + _o); pk[_i] = *(const u32x4*)(KD + _o); pe[_i] = *(const u32x4*)(KE + _o); } \
        if (tid < 256) pv = *(const u32x4*)(P + (size_t)(_rb + vr) * 3072 + 1024 + hd * 256 + sl * 32 + vc * 8); } while (0)
#define GC_STORE(buf) do { LAS unsigned char* _b = lds + (buf) * GC_BUF; \
        _Pragma("unroll") for (int _i = 0; _i < 2; ++_i) { const int _o = (xr0 + 32 * _i) * GC_XSTR + xc * 16; \
            *(LAS u32x4*)(_b + GC_QD + _o) = pq[_i]; *(LAS u32x4*)(_b + GC_KD + _o) = pk[_i]; *(LAS u32x4*)(_b + GC_KE + _o) = pe[_i]; } \
        if (tid < 256) *(LAS u32x4*)(_b + GC_V + vr * GC_VSTR + vc * 16) = pv; } while (0)
        GC_LOAD(0); GC_STORE(0);
        __syncthreads();
#pragma unroll 1
        for (int s = 0; s < 132; ++s) {
            const int cur = s & 1;
            const LAS unsigned char* bq = lds + cur * GC_BUF + GC_QD; const LAS unsigned char* bk = lds + cur * GC_BUF + GC_KD;
            const LAS unsigned char* be = lds + cur * GC_BUF + GC_KE; const LAS unsigned char* bv = lds + cur * GC_BUF + GC_V;
            const int rb = rowbase_of(s);
            if (s + 1 < 132) GC_LOAD(s + 1);
            const f32x4 gv = *(const f32x4*)(GCH + ((size_t)(rb >> 6) * 2 + dir) * 512 + hd * 128 + w * 16 + quad * 4);
#pragma unroll
            for (int q2 = 0; q2 < 2; ++q2) {
                const int id = 2 * w + q2, ti = id >> 2, tj = id & 3;
                f32x4 a4 = (f32x4){0.f, 0.f, 0.f, 0.f};
#pragma unroll
                for (int kk = 0; kk < 4; ++kk) {
                    const bf16x8 af = *(const LAS bf16x8*)(bq + (ti * 16 + fr) * GC_XSTR + (kk * 32 + quad * 8) * 2);
                    const bf16x8 bf = *(const LAS bf16x8*)(bk + (tj * 16 + fr) * GC_XSTR + (kk * 32 + quad * 8) * 2);
                    a4 = __builtin_amdgcn_mfma_f32_16x16x32_bf16(af, bf, a4, 0, 0, 0);
                }
                const int jcol = tj * 16 + fr;
#pragma unroll
                for (int r = 0; r < 4; ++r) { const int irow = ti * 16 + quad * 4 + r; const bool keep = dir == 0 ? (jcol <= irow) : (jcol >= irow);
                    *(LAS bf16_t*)(lds + GC_ATT + irow * GC_ASTR + jcol * 2) = f2bf(keep ? a4[r] : 0.f); }
            }
            const int tm = w >> 1, tn = w & 1;
            f32x4 oacc = (f32x4){0.f, 0.f, 0.f, 0.f};
#pragma unroll
            for (int kk = 0; kk < 4; ++kk) {
                const bf16x8 af = *(const LAS bf16x8*)(bq + (tm * 16 + fr) * GC_XSTR + (kk * 32 + quad * 8) * 2);
                const bf16x8 bf = tr_frag(lds + GC_S, GC_VSTR, kk * 32, tn * 16, lane);
                oacc = __builtin_amdgcn_mfma_f32_16x16x32_bf16(af, bf, oacc, 0, 0, 0);
            }
            __syncthreads();
#pragma unroll
            for (int kk = 0; kk < 2; ++kk) {
                const bf16x8 af = *(const LAS bf16x8*)(lds + GC_ATT + (tm * 16 + fr) * GC_ASTR + (kk * 32 + quad * 8) * 2);
                const bf16x8 bf = tr_frag(bv, GC_VSTR, kk * 32, tn * 16, lane);
                oacc = __builtin_amdgcn_mfma_f32_16x16x32_bf16(af, bf, oacc, 0, 0, 0);
            }
#pragma unroll
            for (int r = 0; r < 4; ++r) O[(size_t)(rb + tm * 16 + quad * 4 + r) * D + hd * 256 + sl * 32 + tn * 16 + fr] = f2bf(oacc[r]);
#pragma unroll
            for (int t2 = 0; t2 < 2; ++t2) {
                f32x4 sa = sacc[t2] * gv;
#pragma unroll
                for (int kk = 0; kk < 2; ++kk) {
                    const bf16x8 af = tr_frag(be, GC_XSTR, kk * 32, w * 16, lane);
                    const bf16x8 bf = tr_frag(bv, GC_VSTR, kk * 32, t2 * 16, lane);
                    sa = __builtin_amdgcn_mfma_f32_16x16x32_bf16(af, bf, sa, 0, 0, 0);
                }
                sacc[t2] = sa;
#pragma unroll
                for (int r = 0; r < 4; ++r) *(LAS bf16_t*)(lds + GC_S + (w * 16 + quad * 4 + r) * GC_VSTR + (t2 * 16 + fr) * 2) = f2bf(sa[r]);
            }
            if (s + 1 < 132) GC_STORE(cur ^ 1);
            __syncthreads();
        }
#undef GC_LOAD
#undef GC_STORE
#undef rowbase_of
    }
}

DI void gla_prep(const Frame& F, int j) {
    const bf16_t* OF = (const bf16_t*)(F.ws + WS_O); const bf16_t* OB = OF + (size_t)TT * D;
    const bf16_t* P = (const bf16_t*)(F.ws + WS_P);
    bf16_t* YG = (bf16_t*)(F.ws + WS_YG);
    const int lane = F.lane;
    const f32x4 ng = *(const f32x4*)(F.inp(I_NORMG) + (size_t)j * 256 + 4 * lane);
    for (int row = F.vcu * 8 + F.wave; row < TT; row += F.G * 8) {
#pragma unroll
        for (int i = 0; i < 4; ++i) {
            const size_t o = (size_t)row * D + 256 * i + 4 * lane;
            const u32x2 a = *(const u32x2*)(OF + o), bb = *(const u32x2*)(OB + o);
            const u32x2 gg = *(const u32x2*)(P + (size_t)row * 3072 + 2048 + 256 * i + 4 * lane);
            f32x4 v; v[0] = bf_lo(a[0]) + bf_lo(bb[0]); v[1] = bf_hi(a[0]) + bf_hi(bb[0]); v[2] = bf_lo(a[1]) + bf_lo(bb[1]); v[3] = bf_hi(a[1]) + bf_hi(bb[1]);
            const float ms = wave_sum(v[0] * v[0] + v[1] * v[1] + v[2] * v[2] + v[3] * v[3]) * (1.0f / 256.0f);
            const float rs = rsqrtf(ms + LN_EPS);
            f32x4 g4; g4[0] = bf_lo(gg[0]); g4[1] = bf_hi(gg[0]); g4[2] = bf_lo(gg[1]); g4[3] = bf_hi(gg[1]);
            f32x4 y;
#pragma unroll
            for (int q = 0; q < 4; ++q) y[q] = v[q] * rs * ng[q] * (g4[q] * sigmoidf_(g4[q]));
            u32x2 p; p[0] = cvt_pk_bf16(y[0], y[1]); p[1] = cvt_pk_bf16(y[2], y[3]);
            *(u32x2*)(YG + o) = p;
        }
    }
}

#ifndef DUP_MASK
#define DUP_MASK 0
#endif
#ifndef OFF_MASK
#define OFF_MASK 0
#endif
#define DUPN(id) (((OFF_MASK >> (id)) & 1) ? 0 : ((DUP_MASK >> (id)) & 1 ? 2 : 1))
#ifndef STOP_AT
#define STOP_AT 0
#endif
DI void dump_h(const Frame& F) {
    const f32x4* H = (const f32x4*)(F.ws + WS_H); f32x4* O = (f32x4*)F.out;
    for (size_t i = (size_t)F.vcu * NTHR + F.tid; i < (size_t)TL * D / 4; i += (size_t)F.G * NTHR) O[i] = H[i];
}
#define STOP_CHECK(code) do { if (STOP_AT == (code)) { const Frame L = launder(F); dump_h(L); return; } } while (0)
#ifdef PROBE
#define STAMP(id) do { if (blockIdx.x == 0 && threadIdx.x == 0) { const unsigned long long _n = __builtin_amdgcn_s_memrealtime(); volatile LAS unsigned* _d = (volatile LAS unsigned*)(F.lds + LDS_MISC + 512); \
    _d[(id)] += (unsigned)(_n - *(volatile LAS unsigned long long*)(F.lds + LDS_MISC + 768)); *(volatile LAS unsigned long long*)(F.lds + LDS_MISC + 768) = _n; } } while (0)
#else
#define STAMP(id) do { } while (0)
#endif
__global__ void __launch_bounds__(NTHR, 2) fwd_kernel(Args args) {
    extern __shared__ __attribute__((aligned(16))) unsigned char lds_raw[];
    Frame F;
    F.lds = (LAS unsigned char*)lds_raw; F.ws = args.ws; F.in = (inarr_t)__builtin_amdgcn_kernarg_segment_ptr(); F.out = args.out;
    F.tid = threadIdx.x; F.lane = F.tid & 63; F.wave = __builtin_amdgcn_readfirstlane(F.tid >> 6);
    F.G = gridDim.x; { const int bx = blockIdx.x; F.vcu = (F.G % 8 == 0) ? (bx % 8) * (F.G / 8) + bx / 8 : bx; }
    for (int u = F.tid; u < 1024 / 4; u += NTHR) ((LAS unsigned*)(F.lds + LDS_MISC))[u] = 0u;
    __syncthreads();
    F.ws = (unsigned char*)(GBL unsigned char*)(unsigned long long)F.ws; F.out = (float*)(GBL float*)(unsigned long long)F.out;
    XcdBarrier bar = xcd_barrier_post((unsigned*)(F.ws + WS_CTL), (volatile LAS unsigned*)(F.lds + LDS_MISC));
#define GRID_BAR_() do { XcdBarrier _b = bar; { unsigned long long _x = (unsigned long long)_b.bar; asm volatile("" : "+s"(_x)); _b.bar = (unsigned*)(GBL unsigned*)_x; } asm volatile("" : "+s"(_b.x)); xcd_barrier(_b); } while (0)
#define GRID_BAR(id) do { GRID_BAR_(); STAMP(id); } while (0)
#ifdef PROBE
    if (blockIdx.x == 0 && threadIdx.x == 0) *(volatile LAS unsigned long long*)(F.lds + LDS_MISC + 768) = __builtin_amdgcn_s_memrealtime();
#endif
    LAS int* mt = (LAS int*)(F.lds + LDS_MISC + 256);
    volatile LAS int* qslot = (volatile LAS int*)(F.lds + LDS_MISC + 64);

    for (int _r = 0; _r < DUPN(0); ++_r) { if (_r) GRID_BAR(0);
    for (;;) {
        const Frame L = launder(F);
        __syncthreads();
        if (L.tid == 0) *qslot = (int)__hip_atomic_fetch_add((unsigned*)(L.ws + WS_CTL) + CW_QUEUE + 32 * _r, 1u, __ATOMIC_RELAXED, __HIP_MEMORY_SCOPE_AGENT);
        __syncthreads();
        const int q = __builtin_amdgcn_readfirstlane(*qslot);
        if (q < PI_S5 + PI_MOD) { prologue_item(L, q); continue; }
        const int base = PI_S5 + PI_MOD + (q - (PI_S5 + PI_MOD)) * 8;
        if (base >= PI_TOTAL) break;
#pragma unroll 1
        for (int it = base; it < base + 8 && it < PI_TOTAL; ++it) prologue_item(L, it);
    }
    }
    GRID_BAR(0);
if (DUPN(1))     { const Frame L = launder(F); row_pass<IN_INIT, OUT_S5>(L, TT, 0, nullptr, nullptr, 0, 0, nullptr, nullptr, 0); }
    GRID_BAR(1);
#pragma unroll 1
    for (int layer = 0; layer < DEPTH; ++layer) {
        const int j = layer >> 1;
        if ((layer & 1) == 0) {
for (int _r = 0; _r < DUPN(2); ++_r) { if (_r) GRID_BAR(2);
            { const Frame L = launder(F); ProbS5E p{(const bf16_t*)(L.ws + WS_UP), (const bf16_t*)(L.ws + WS_S5PIN) + (size_t)j * 64 * 256 * 512, (float*)(L.ws + WS_E), L.G, L.vcu}; g8::gemm_phase(L.lds, L.tid, p); }
}
            GRID_BAR(2);
for (int _r = 0; _r < DUPN(3); ++_r) { if (_r) GRID_BAR(3);
            { const Frame L = launder(F); s5_scan(L, j); }
}
            GRID_BAR(3);
for (int _r = 0; _r < DUPN(4); ++_r) { if (_r) GRID_BAR(4);
            { const Frame L = launder(F); ProbS5Y p{(const bf16_t*)(L.ws + WS_UP), (const bf16_t*)(L.ws + WS_S5M) + (size_t)j * 64 * 512 * 768, (bf16_t*)(L.ws + WS_YG), L.G, L.vcu}; g8::gemm_phase(L.lds, L.tid, p); }
}
            GRID_BAR(4);
if (DUPN(5))             { const Frame L = launder(F); ProbGLU p{(const bf16_t*)(L.ws + WS_YG), (const bf16_t*)(L.ws + WS_WGLU) + (size_t)j * 2048 * 1024, (float*)(L.ws + WS_H), (const float*)(L.ws + WS_MOD) + (size_t)layer * 5 * 6144, L.G, L.vcu}; g8::gemm_phase(L.lds, L.tid, p); }
        } else {
for (int _r = 0; _r < DUPN(10); ++_r) { if (_r) GRID_BAR(10);
            { const Frame L = launder(F); ProbProj p{(const bf16_t*)(L.ws + WS_UB), (const bf16_t*)(L.ws + WS_WIN) + (size_t)j * 3072 * 1024, (bf16_t*)(L.ws + WS_P), L.G, L.vcu}; g8::gemm_phase(L.lds, L.tid, p); }
}
            GRID_BAR(10);
for (int _r = 0; _r < DUPN(11); ++_r) { if (_r) GRID_BAR(11);
            { const Frame L = launder(F); gla_gates(L, j); }
}
            GRID_BAR(11);
for (int _r = 0; _r < DUPN(12); ++_r) { if (_r) GRID_BAR(12);
            { const Frame L = launder(F); gla_chunks(L); }
}
            GRID_BAR(12);
for (int _r = 0; _r < DUPN(13); ++_r) { if (_r) GRID_BAR(13);
            { const Frame L = launder(F); gla_prep(L, j); }
}
            GRID_BAR(13);
if (DUPN(14))             { const Frame L = launder(F); ProbOut p{(const bf16_t*)(L.ws + WS_YG), (const bf16_t*)(L.ws + WS_WOUT) + (size_t)j * 1024 * 1024, (float*)(L.ws + WS_H), (const float*)(L.ws + WS_MOD) + (size_t)layer * 5 * 6144, layer == 3 ? TL / 256 : TT / 256, L.G, L.vcu}; g8::gemm_phase(L.lds, L.tid, p); }
        }
        GRID_BAR((layer & 1) ? 14 : 5);
        if (DUPN(6)) { const Frame L = launder(F);
          row_pass<IN_LN, OUT_ROUTER>(L, layer == 3 ? TL : TT, layer, L.inp(I_LN1G) + (size_t)layer * D, L.inp(I_LN1B) + (size_t)layer * D, layer, 3,
                                      (const bf16_t*)(L.ws + WS_WR) + (size_t)layer * 32 * 1024, L.inp(I_BROUTER) + (size_t)layer * 32, layer); }
        GRID_BAR(6);
        if (STOP_AT != 0 && STOP_AT == layer * 2 + 1) { const Frame L = launder(F); dump_h(L); return; }
for (int _r = 0; _r < DUPN(7); ++_r) { if (_r) GRID_BAR(7);
        { const Frame L = launder(F);
          __syncthreads();
          if (L.tid == 0) { const unsigned* cw = (const unsigned*)(L.ws + WS_CTL) + CW_CNT + layer * 32; int acc = 0; mt[32] = 0; for (int e = 0; e < 32; ++e) { const int c = (int)cw[e]; mt[e] = c; acc += (c + 255) >> 8; mt[33 + e] = acc; } }
          __syncthreads();
          ProbUp p{L.ws + WS_UB8, L.ws + WS_WUP + (size_t)layer * 32 * 2048 * 1024, L.inp(I_BUP) + (size_t)layer * 32 * 2048, (const int*)(L.ws + WS_TOKL),
                   L.ws + WS_ACT, MoeTab{mt}, L.G, L.vcu}; g8::gemm_phase(L.lds, L.tid, p); }
}
        GRID_BAR(7);
for (int _r = 0; _r < DUPN(8); ++_r) { if (_r) GRID_BAR(8);
        { const Frame L = launder(F);
          ProbDown p{L.ws + WS_ACT, L.ws + WS_WDN + (size_t)layer * 32 * 1024 * 1024, L.inp(I_BDN) + (size_t)layer * 32 * 1024, (const int*)(L.ws + WS_TOKL),
                     (const float*)(L.ws + WS_GATEL), (bf16_t*)(L.ws + WS_FEXP), MoeTab{mt}, L.G, L.vcu}; g8::gemm_phase(L.lds, L.tid, p); }
}
        GRID_BAR(8);
        if (DUPN(9)) { const Frame L = launder(F);
          const float* l2g = L.inp(I_LN2G) + (size_t)layer * D; const float* l2b = L.inp(I_LN2B) + (size_t)layer * D;
          if (layer == 3) row_pass<IN_COMBINE, OUT_FINAL>(L, TL, layer, l2g, l2b, 0, 0, nullptr, nullptr, 0);
          else if (layer & 1) row_pass<IN_COMBINE, OUT_S5>(L, TT, layer, l2g, l2b, layer + 1, 0, nullptr, nullptr, 0);
          else row_pass<IN_COMBINE, OUT_CMLR>(L, TT, layer, l2g, l2b, layer + 1, 0, (const bf16_t*)(L.ws + WS_WLR) + (size_t)((layer + 1) >> 1) * 32 * 1024, nullptr, 0); }
        if (layer < 3) GRID_BAR(9);
#ifdef PROBE
        else GRID_BAR(9);
#endif
        if (STOP_AT != 0 && STOP_AT == layer * 2 + 2) { const Frame L = launder(F); dump_h(L); return; }
    }
#ifdef PROBE
    {
        unsigned* pw = (unsigned*)(F.ws + WS_CTL) + 4096;
        if (blockIdx.x == 0 && threadIdx.x == 0) { volatile LAS unsigned* d = (volatile LAS unsigned*)(F.lds + LDS_MISC + 512); pw[0] = d[PROBE_A]; pw[1] = d[PROBE_B]; }
        GRID_BAR_();
        const float va = sqrtf((float)pw[0] * 0.01f * (float)(PROBE_SA)), vb = (float)pw[1] * 0.01f * (float)(PROBE_SB);
        f32x4* O = (f32x4*)F.out;
        for (size_t i = (size_t)blockIdx.x * NTHR + threadIdx.x; i < (size_t)TL * D / 4; i += (size_t)gridDim.x * NTHR) { f32x4 v = (f32x4){va, va, va, va}; if (i == 0) v[0] = vb; O[i] = v; }
    }
#endif
}

extern "C" void kernel_launch(void* const* d_in, const int* in_sizes, int n_in, void* d_out, int out_size, void* d_ws, size_t ws_size, hipStream_t stream) {
    static int grid = 0;
    if (grid == 0) {
        if (n_in != 30 || out_size != TL * D || ws_size < WS_END) { fprintf(stderr, "kernel_launch: unexpected shapes (n_in %d out %d ws %zu need %zu)\n", n_in, out_size, ws_size, (size_t)WS_END); grid = -1; return; }
        int dev = 0, cus = 0, per_cu = 0;
        if (hipGetDevice(&dev) != hipSuccess || hipDeviceGetAttribute(&cus, hipDeviceAttributeMultiprocessorCount, dev) != hipSuccess) { grid = -1; return; }
        if (hipFuncSetAttribute((const void*)fwd_kernel, hipFuncAttributeMaxDynamicSharedMemorySize, LDS_BYTES) != hipSuccess) { fprintf(stderr, "kernel_launch: hipFuncSetAttribute failed\n"); grid = -1; return; }
        if (hipOccupancyMaxActiveBlocksPerMultiprocessor(&per_cu, (const void*)fwd_kernel, NTHR, LDS_BYTES) != hipSuccess || per_cu < 1) { fprintf(stderr, "kernel_launch: occupancy query says %d\n", per_cu); }
        (void)hipGetLastError();
        grid = cus;
    }
    if (grid < 0) return;
    (void)in_sizes;
    if (hipMemsetAsync((char*)d_ws + WS_CTL, 0, CTL_BYTES, stream) != hipSuccess) return;
    Args a{};
    for (int i = 0; i < 30; ++i) a.in[i] = (const float*)d_in[i];
    a.out = (float*)d_out; a.ws = (unsigned char*)d_ws;
    hipLaunchKernelGGL(fwd_kernel, dim3(grid), dim3(NTHR), LDS_BYTES, stream, a);
}
```

```cpp
#include <hip/hip_runtime.h>
#include <cstdio>
#include <cstdint>

#define LAS __attribute__((address_space(3)))
#define GBL __attribute__((address_space(1)))
#define DI __device__ __forceinline__
typedef unsigned short bf16_t;
typedef short bf16x8 __attribute__((ext_vector_type(8)));
typedef short s16x4 __attribute__((ext_vector_type(4)));
typedef float f32x4 __attribute__((ext_vector_type(4)));
typedef float f32x16 __attribute__((ext_vector_type(16)));
typedef unsigned u32x4 __attribute__((ext_vector_type(4)));
typedef unsigned u32x2 __attribute__((ext_vector_type(2)));

constexpr int D = 1024, NB = 4, SEQ = 8192, LCTX = 256, DEPTH = 4;
constexpr int TL = NB * SEQ, TC = NB * LCTX, TT = TL + TC;
constexpr int NTHR = 512;
constexpr int S5T = 32;
constexpr int S5ROWS = 1280;
constexpr int S5VALID = 1056;
constexpr int NEXP = 32, TOPK = 4;
constexpr int ACT_ROWS = TT * TOPK + NEXP * 256;
constexpr float DN_ALPHA = 1.6817928305074292f;
constexpr float LN_EPS = 1e-5f;
constexpr int LDS_BYTES = 147456;
constexpr int LDS_MISC = LDS_BYTES - 1024;

constexpr size_t al256(size_t x) { return (x + 255) & ~(size_t)255; }
constexpr size_t CTL_BYTES = 131072;
constexpr size_t WS_CTL   = 0;
constexpr size_t WS_MOD   = WS_CTL + CTL_BYTES;
constexpr size_t WS_H     = al256(WS_MOD + (size_t)DEPTH * 5 * 6144 * 4);
constexpr size_t WS_UB    = al256(WS_H + (size_t)TT * D * 2);
constexpr size_t WS_UP    = al256(WS_UB + (size_t)TT * D * 2);
constexpr size_t WS_E     = al256(WS_UP + (size_t)64 * S5ROWS * 768 * 2);
constexpr size_t WS_YG    = al256(WS_E + (size_t)64 * S5ROWS * 256 * 4);
constexpr size_t WS_P     = al256(WS_YG + (size_t)TT * D * 2);
constexpr size_t WS_ALR   = al256(WS_P + (size_t)TT * 3072 * 2);
constexpr size_t WS_QKE   = al256(WS_ALR + (size_t)TT * 32 * 4);
constexpr size_t WS_GCH   = al256(WS_QKE + (size_t)6 * TT * 512 * 2);
constexpr size_t WS_O     = al256(WS_GCH + (size_t)528 * 2 * 512 * 4);
constexpr size_t WS_SEGL  = al256(WS_O + (size_t)2 * TT * D * 2);
constexpr size_t WS_SEGG  = al256(WS_SEGL + (size_t)32 * 11 * 2 * 16384 * 4);
constexpr size_t WS_TOKL  = al256(WS_SEGG + (size_t)32 * 11 * 128 * 4);
constexpr size_t WS_GATEL = al256(WS_TOKL + (size_t)NEXP * TT * 4);
constexpr size_t WS_ACT   = al256(WS_GATEL + (size_t)NEXP * TT * 4);
constexpr size_t WS_UB8   = al256(WS_ACT + (size_t)ACT_ROWS * D);
constexpr size_t WS_FEXP  = al256(WS_UB8 + (size_t)TT * D);
constexpr size_t WS_WGLU  = al256(WS_FEXP + (size_t)TT * 4 * D * 2);
constexpr size_t WS_WIN   = al256(WS_WGLU + (size_t)2 * 2048 * D * 2);
constexpr size_t WS_WOUT  = al256(WS_WIN + (size_t)2 * 3072 * D * 2);
constexpr size_t WS_WUP   = al256(WS_WOUT + (size_t)2 * D * D * 2);
constexpr size_t WS_WDN   = al256(WS_WUP + (size_t)DEPTH * NEXP * 2048 * D);
constexpr size_t WS_WR    = al256(WS_WDN + (size_t)DEPTH * NEXP * D * D);
constexpr size_t WS_WLR   = al256(WS_WR + (size_t)DEPTH * 32 * D * 2);
constexpr size_t WS_S5M   = al256(WS_WLR + (size_t)2 * 32 * D * 2);
constexpr size_t WS_S5PIN = al256(WS_S5M + (size_t)2 * 64 * 512 * 768 * 2);
constexpr size_t WS_S5AT  = al256(WS_S5PIN + (size_t)2 * 64 * 256 * 512 * 2);
constexpr size_t WS_END   = al256(WS_S5AT + (size_t)2 * 64 * 2 * 64 * 2 * 4);

#define CW_QUEUE 3520
#define CW_CNT   3584
#define CW_XRANK 3840

#define XB_TMO      128
#define XB_XCNT(j)  (256  + 64 * (j))
#define XB_XSUB(j)  (1280 + 64 * (j))
#define XB_XGEN(j)  (2304 + 64 * (j))
#define XB_TOP      3328
#define XB_TOPGEN   3392
#define XCD_BAR_WORDS 3456
#define XB_SPIN_CAP (1u << 18)

__device__ __forceinline__ unsigned xb_ld(unsigned* p)              { return __hip_atomic_load(p, __ATOMIC_RELAXED, __HIP_MEMORY_SCOPE_AGENT); }
__device__ __forceinline__ unsigned xb_add(unsigned* p, unsigned v) { return __hip_atomic_fetch_add(p, v, __ATOMIC_RELAXED, __HIP_MEMORY_SCOPE_AGENT); }
__device__ __forceinline__ unsigned xb_xcc_id() { return (unsigned)__builtin_amdgcn_s_getreg((3 << 11) | 20) & 0xFu; }
#define XB_SPIN(cond, bar) do { unsigned _sp = 0; while (cond) { __builtin_amdgcn_s_sleep(1); \
    if ((++_sp & 255u) == 0u) { if (xb_ld(&(bar)[XB_TMO])) break; if (_sp > XB_SPIN_CAP) { atomicAdd(&(bar)[XB_TMO], 1u); break; } } } } while (0)

struct XcdBarrier { unsigned* bar; unsigned x; volatile LAS unsigned* st; };

__device__ __forceinline__ XcdBarrier xcd_barrier_post(unsigned* bar, volatile LAS unsigned* st) {
    XcdBarrier b; b.bar = bar; b.x = xb_xcc_id(); b.st = st;
    if (threadIdx.x == 0) (void)xb_add(&bar[XB_XCNT(b.x)], 1u);
    return b;
}
__device__ __forceinline__ void xcd_barrier_complete(unsigned* bar, unsigned x, unsigned& nloc, unsigned& nx) {
    const unsigned G = gridDim.x * gridDim.y * gridDim.z;
    unsigned sum, cnt, mine, sp = 0u;
    for (;;) {
        sum = 0u; cnt = 0u; mine = 0u;
#pragma unroll
        for (unsigned j = 0; j < 16; ++j) { const unsigned c = xb_ld(&bar[XB_XCNT(j)]); sum += c; cnt += (c > 0u) ? 1u : 0u; mine = (j == x) ? c : mine; }
        if (sum == G) break;
        __builtin_amdgcn_s_sleep(1);
        if ((++sp & 255u) == 0u) { if (xb_ld(&bar[XB_TMO])) break; if (sp > XB_SPIN_CAP) { atomicAdd(&bar[XB_TMO], 1u); break; } }
    }
    nloc = mine > 0u ? mine : 1u; nx = cnt > 0u ? cnt : 1u;
}
__device__ __forceinline__ void xcd_barrier(const XcdBarrier& b) {
    asm volatile("s_waitcnt vmcnt(0)" ::: "memory");
    __syncthreads();
    if (threadIdx.x == 0) {
        unsigned* bar = b.bar;
        __builtin_amdgcn_s_waitcnt(0);
        unsigned nloc = b.st[0], nx = b.st[1];
        if (nloc == 0u) { xcd_barrier_complete(bar, b.x, nloc, nx); b.st[0] = nloc; b.st[1] = nx; }
        const unsigned old = xb_add(&bar[XB_XSUB(b.x)], 1u);
        const unsigned gen = old / nloc;
        if (old + 1u == (gen + 1u) * nloc) {
            __builtin_amdgcn_fence(__ATOMIC_RELEASE, "agent");
            asm volatile("s_waitcnt vmcnt(0)" ::: "memory");
            const unsigned og = xb_add(&bar[XB_TOP], 1u);
            const unsigned tg = og / nx;
            if (og + 1u == (tg + 1u) * nx) xb_add(&bar[XB_TOPGEN], 1u);
            else XB_SPIN(xb_ld(&bar[XB_TOPGEN]) == tg, bar);
            __builtin_amdgcn_fence(__ATOMIC_ACQUIRE, "agent");
            xb_add(&bar[XB_XGEN(b.x)], 1u);
            asm volatile("s_waitcnt vmcnt(0)" ::: "memory");
        } else {
            XB_SPIN(xb_ld(&bar[XB_XGEN(b.x)]) == gen, bar);
            __builtin_amdgcn_fence(__ATOMIC_ACQUIRE, "agent");
            asm volatile("s_waitcnt vmcnt(0)" ::: "memory");
        }
    }
    __syncthreads();
}

typedef float f32x2_t __attribute__((ext_vector_type(2)));
typedef __bf16 bf16x2_t __attribute__((ext_vector_type(2)));
DI unsigned cvt_pk_bf16(float lo, float hi) { f32x2_t v; v.x = lo; v.y = hi; return __builtin_bit_cast(unsigned, __builtin_convertvector(v, bf16x2_t)); }
DI unsigned pack_fp8x4(float a, float b, float c, float d) { unsigned w = 0u; w = __builtin_amdgcn_cvt_pk_fp8_f32(a, b, w, false); w = __builtin_amdgcn_cvt_pk_fp8_f32(c, d, w, true); return w; }
typedef _Float16 f16x2_t __attribute__((ext_vector_type(2)));
DI unsigned cvt_pk_f16(float lo, float hi) { f32x2_t v; v.x = lo; v.y = hi; return __builtin_bit_cast(unsigned, __builtin_convertvector(v, f16x2_t)); }
DI float h_lo(unsigned u) { return (float)__builtin_bit_cast(f16x2_t, u).x; }
DI float h_hi(unsigned u) { return (float)__builtin_bit_cast(f16x2_t, u).y; }
DI float bf_lo(unsigned u) { return __uint_as_float(u << 16); }
DI float bf_hi(unsigned u) { return __uint_as_float(u & 0xffff0000u); }
DI float bf2f(bf16_t b) { return __uint_as_float(((unsigned)b) << 16); }
DI bf16_t f2bf(float f) { return (bf16_t)(cvt_pk_bf16(f, 0.f) & 0xffffu); }
DI float wave_sum(float v) {
#pragma unroll
    for (int m = 32; m >= 1; m >>= 1) v += __shfl_xor(v, m, 64);
    return v;
}
DI float sigmoidf_(float x) { return __builtin_amdgcn_rcpf(1.0f + __expf(-x)); }
DI float gelu_tanh(float x) { const float z = 0.7978845608028654f * (x + 0.044715f * x * x * x); const float t = 1.0f - 2.0f * __builtin_amdgcn_rcpf(__expf(2.0f * z) + 1.0f); return 0.5f * x * (1.0f + t); }
DI int perm32(int rho) { return 8 * ((rho >> 2) & 3) + 4 * (rho >> 4) + (rho & 3); }
DI int inv32(int o) { return 16 * ((o >> 2) & 1) + 4 * (o >> 3) + (o & 3); }

namespace g8 {
constexpr int BM = 256, BK = 64, HALF = 128, HTB = HALF * BK * 2, STAGE_BYTES = 8 * HTB;
DI int lds_byte(int r, int c) { const int st = (r >> 4) * 2 + (c >> 5), rr = r & 15, cc = c & 31, ob = rr * 64 + cc * 2; return st * 1024 + (ob ^ (((ob >> 9) & 1) << 5)); }
DI void stage_rc(int b, int& R, int& C) { const int st = b / 1024, sb = b % 1024, swz = sb ^ (((sb >> 9) & 1) << 5); R = (st >> 1) * 16 + swz / 64; C = (st & 1) * 32 + (swz % 64) / 2; }

typedef f32x4 Acc[2][2][4][2];
typedef int v8i_t __attribute__((ext_vector_type(8)));
typedef short s16x16_t __attribute__((ext_vector_type(16)));
DI bf16x8 lo8(v8i_t v) { const s16x16_t s = __builtin_bit_cast(s16x16_t, v); return __builtin_shufflevector(s, s, 0, 1, 2, 3, 4, 5, 6, 7); }
DI bf16x8 hi8(v8i_t v) { const s16x16_t s = __builtin_bit_cast(s16x16_t, v); return __builtin_shufflevector(s, s, 8, 9, 10, 11, 12, 13, 14, 15); }
DI v8i_t cat8(bf16x8 a, bf16x8 b) { return __builtin_bit_cast(v8i_t, __builtin_shufflevector(a, b, 0, 1, 2, 3, 4, 5, 6, 7, 8, 9, 10, 11, 12, 13, 14, 15)); }

template <class P>
DI void gemm_phase(LAS unsigned char* lds, const int tid, P& prob) {
    const int wid = __builtin_amdgcn_readfirstlane(tid >> 6), lane = tid & 63, wr = wid >> 2, wc = wid & 3, fr = lane & 15, fq = lane >> 4;
    const int nt = prob.Kbytes() / (BK * 2), lda = prob.ldaB(), ldb = prob.ldbB();
    unsigned cvA[2][2], nvA[2][2], voffB[2];
#pragma unroll
    for (int i = 0; i < 2; ++i) { int R, C; stage_rc(tid * 16 + i * 8192, R, C);
        voffB[i] = (unsigned)(R * ldb + C * 2);
        cvA[0][i] = (unsigned)(R * lda + C * 2); cvA[1][i] = (unsigned)((R + HALF) * lda + C * 2);
        nvA[0][i] = cvA[0][i]; nvA[1][i] = cvA[1][i]; }
    const size_t kstepA = (size_t)prob.kstepA(), kstepB = (size_t)prob.kstepB();
    const size_t hstepB = (size_t)HALF * ldb;
    const unsigned ldsw = (unsigned)wid * 1024u;
    const int aoff = lds_byte(wr * 64 + fr, fq * 8), boff = lds_byte(wc * 32 + fr, fq * 8);
#define G8_SA(b, h) (((b) * 2 + (h)) * HTB)
#define G8_SB(b, h) ((4 + (b) * 2 + (h)) * HTB)
#define G8_STAGE(bufoff, gbase, voff) do { _Pragma("unroll") for (int _i = 0; _i < 2; ++_i) \
        __builtin_amdgcn_global_load_lds((const unsigned*)((const char*)(gbase) + (voff)[_i]), (LAS unsigned*)(lds + (bufoff) + ldsw + _i * 8192), 16, 0, 0); } while (0)
#define G8_STAGE_SEL(bufoff, gbase, h, sel) do { _Pragma("unroll") for (int _i = 0; _i < 2; ++_i) { const unsigned _vo = (P::GATHER && (sel)) ? nvA[h][_i] : cvA[h][_i]; \
        __builtin_amdgcn_global_load_lds((const unsigned*)((const char*)(gbase) + _vo), (LAS unsigned*)(lds + (bufoff) + ldsw + _i * 8192), 16, 0, 0); } } while (0)
#define G8_LDA(dst, b, h) do { _Pragma("unroll") for (int m = 0; m < 4; ++m) dst[m] = cat8(*(const LAS bf16x8*)(lds + G8_SA(b, h) + aoff + m * 2048), *(const LAS bf16x8*)(lds + G8_SA(b, h) + aoff + m * 2048 + 1024)); } while (0)
#define G8_LDB(dst, b, h) do { _Pragma("unroll") for (int n = 0; n < 2; ++n) dst[n] = cat8(*(const LAS bf16x8*)(lds + G8_SB(b, h) + boff + n * 2048), *(const LAS bf16x8*)(lds + G8_SB(b, h) + boff + n * 2048 + 1024)); } while (0)
#define G8_MMA(ai, bj, At, Bt) do { __builtin_amdgcn_s_setprio(1); \
        if (P::FP8) { _Pragma("unroll") for (int m = 0; m < 4; ++m) _Pragma("unroll") for (int n = 0; n < 2; ++n) \
            asm volatile("v_mfma_f32_16x16x128_f8f6f4 %0, %1, %2, %0" : "+v"(acc[ai][bj][m][n]) : "v"(Bt[n]), "v"(At[m])); } \
        else { _Pragma("unroll") for (int m = 0; m < 4; ++m) _Pragma("unroll") for (int n = 0; n < 2; ++n) { \
            acc[ai][bj][m][n] = __builtin_amdgcn_mfma_f32_16x16x32_bf16(lo8(Bt[n]), lo8(At[m]), acc[ai][bj][m][n], 0, 0, 0); \
            acc[ai][bj][m][n] = __builtin_amdgcn_mfma_f32_16x16x32_bf16(hi8(Bt[n]), hi8(At[m]), acc[ai][bj][m][n], 0, 0, 0); } } \
        __builtin_amdgcn_s_setprio(0); } while (0)
#define G8_WAIT_V(n) asm volatile("s_waitcnt vmcnt(" #n ")" ::: "memory")
#define G8_WAIT_L(n) asm volatile("s_waitcnt lgkmcnt(" #n ")" ::: "memory")
#define G8_BAR __builtin_amdgcn_s_barrier()
#define G8_SCHED __builtin_amdgcn_sched_barrier(0)
    typename P::Unit cur, nxt; int ui = 0;
    if (!prob.next(0, cur)) return;
    Acc acc;
#pragma unroll
    for (int a = 0; a < 2; ++a)
#pragma unroll
        for (int b = 0; b < 2; ++b)
#pragma unroll
            for (int m = 0; m < 4; ++m)
#pragma unroll
                for (int n = 0; n < 2; ++n) acc[a][b][m][n] = (f32x4){0.f, 0.f, 0.f, 0.f};
    v8i_t At[4], B0[2], B1[2];
    const char* cA = cur.a; const char* cB = cur.b;
    if (P::GATHER) prob.gather(cur, tid, cvA);
    G8_STAGE(G8_SB(0, 0), cB, voffB); G8_STAGE(G8_SA(0, 0), cA, cvA[0]); G8_STAGE(G8_SB(0, 1), cB + hstepB, voffB); G8_STAGE(G8_SA(0, 1), cA, cvA[1]);
    if (wr == 1) G8_BAR;
    G8_WAIT_V(4); G8_BAR;
    G8_STAGE(G8_SB(1, 0), cB + kstepB, voffB); G8_STAGE(G8_SA(1, 0), cA + kstepA, cvA[0]); G8_STAGE(G8_SB(1, 1), cB + hstepB + kstepB, voffB);
    G8_WAIT_V(6); G8_BAR;
    for (;;) {
        const bool has_next = prob.next(ui + 1, nxt);
        const char* nA = has_next ? nxt.a : cA; const char* nB = has_next ? nxt.b : cB;
        if (P::GATHER) { if (has_next) prob.gather(nxt, tid, nvA); else {
#pragma unroll
            for (int h = 0; h < 2; ++h)
#pragma unroll
                for (int i = 0; i < 2; ++i) nvA[h][i] = cvA[h][i]; } }
#pragma unroll 1
        for (int t = 0; t < nt; t += 2) {
            const bool last = (t == nt - 2);
            const char* a1 = cA + (size_t)(t + 1) * kstepA;
            const char* a2 = last ? nA : cA + (size_t)(t + 2) * kstepA; const char* b2 = last ? nB : cB + (size_t)(t + 2) * kstepB;
            const char* a3 = a2 + kstepA; const char* b3 = b2 + kstepB;
            G8_LDB(B0, 0, 0); G8_SCHED; G8_LDA(At, 0, 0); G8_STAGE(G8_SA(1, 1), a1, cvA[1]);
            G8_WAIT_L(8); G8_BAR; G8_WAIT_L(0); G8_MMA(0, 0, At, B0); G8_BAR; G8_SCHED;
            G8_LDB(B1, 0, 1); G8_STAGE(G8_SB(0, 0), b2, voffB);
            G8_BAR; G8_WAIT_L(0); G8_MMA(0, 1, At, B1); G8_BAR;
            G8_LDA(At, 0, 1); G8_STAGE_SEL(G8_SA(0, 0), a2, 0, last);
            G8_BAR; G8_WAIT_L(0); G8_MMA(1, 0, At, B0); G8_BAR; G8_SCHED;
            G8_STAGE(G8_SB(0, 1), b2 + hstepB, voffB);
            G8_WAIT_V(6); G8_BAR; G8_MMA(1, 1, At, B1); G8_BAR;
            G8_LDB(B0, 1, 0); G8_SCHED; G8_LDA(At, 1, 0); G8_STAGE_SEL(G8_SA(0, 1), a2, 1, last);
            G8_WAIT_L(8); G8_BAR; G8_WAIT_L(0); G8_MMA(0, 0, At, B0); G8_BAR; G8_SCHED;
            G8_LDB(B1, 1, 1); G8_STAGE(G8_SB(1, 0), b3, voffB);
            G8_BAR; G8_WAIT_L(0); G8_MMA(0, 1, At, B1); G8_BAR;
            G8_LDA(At, 1, 1); G8_STAGE_SEL(G8_SA(1, 0), a3, 0, last);
            G8_BAR; G8_WAIT_L(0); G8_MMA(1, 0, At, B0); G8_BAR; G8_SCHED;
            G8_STAGE(G8_SB(1, 1), b3 + hstepB, voffB);
            G8_WAIT_V(6); G8_BAR; G8_MMA(1, 1, At, B1); G8_BAR;
        }
        if (P::FP8) asm volatile("s_nop 15\n\ts_nop 15" ::: "memory");
        prob.epi(acc, cur, wr, wc, fr, fq);
        if (!has_next) break;
#pragma unroll
        for (int a = 0; a < 2; ++a)
#pragma unroll
            for (int b = 0; b < 2; ++b)
#pragma unroll
                for (int m = 0; m < 4; ++m)
#pragma unroll
                    for (int n = 0; n < 2; ++n) acc[a][b][m][n] = (f32x4){0.f, 0.f, 0.f, 0.f};
        cur = nxt; cA = nA; cB = nB; ++ui;
        if (P::GATHER) {
#pragma unroll
            for (int h = 0; h < 2; ++h)
#pragma unroll
                for (int i = 0; i < 2; ++i) cvA[h][i] = nvA[h][i]; }
    }
    G8_WAIT_V(0);
    if (wr == 0) G8_BAR;
    G8_BAR;
#undef G8_SA
#undef G8_SB
#undef G8_STAGE
#undef G8_STAGE_SEL
#undef G8_LDA
#undef G8_LDB
#undef G8_MMA
#undef G8_WAIT_V
#undef G8_WAIT_L
#undef G8_BAR
#undef G8_SCHED
}
}

struct Args { const float* in[30]; float* out; unsigned char* ws; };
typedef const float* fptr_t;
typedef __attribute__((address_space(4))) const fptr_t* inarr_t;
struct Frame {
    LAS unsigned char* lds; unsigned char* ws; inarr_t in; float* out;
    int tid, lane, wave, G, vcu;
    DI const float* inp(int i) const { return (const float*)(const GBL float*)in[i]; }
};
DI Frame launder(const Frame& F0) {
    Frame F = F0;
    { unsigned long long x = (unsigned long long)F.ws; asm volatile("" : "+s"(x)); F.ws = (unsigned char*)(GBL unsigned char*)x; }
    { unsigned long long x = (unsigned long long)F.out; asm volatile("" : "+s"(x)); F.out = (float*)(GBL float*)x; }
    asm volatile("" : "+s"(F.in));
    asm volatile("" : "+v"(F.tid)); F.lane = F.tid & 63; F.wave = __builtin_amdgcn_readfirstlane(F.tid >> 6);
    asm volatile("" : "+s"(F.G)); asm volatile("" : "+s"(F.vcu));
    return F;
}
enum { I_X = 0, I_C, I_CTX, I_CCTX, I_WADA, I_BADA, I_LN1G, I_LN1B, I_LN2G, I_LN2B, I_LAMRE, I_LAMIM, I_LOGSTEP, I_BRE, I_BIM, I_CRE, I_CIM, I_S5D, I_WGLU,
       I_WIN, I_WA2, I_BA2, I_NORMG, I_WOUT, I_WROUTER, I_BROUTER, I_WUP, I_BUP, I_WDN, I_BDN };

DI const float* modp(const Frame& F, int layer, int b, int which) { return (const float*)(F.ws + WS_MOD) + ((size_t)(layer * 5 + b) * 6 + which) * 1024; }

struct ProbS5E {
    static constexpr bool GATHER = false;
    struct Unit { const char* a; const char* b; int g, rt; };
    const bf16_t* UP; const bf16_t* PIN; float* E; int G, vcu;
    static constexpr bool FP8 = false; DI int Kbytes() const { return 1024; } DI int ldaB() const { return 1536; } DI int ldbB() const { return 1024; } DI int kstepA() const { return 128; } DI int kstepB() const { return 128; }
    DI bool next(int i, Unit& u) const {
        const int L = i * G + vcu; if (L >= 64 * 5) return false;
        u.g = L / 5; u.rt = L % 5;
        u.a = (const char*)(UP + ((size_t)u.g * S5ROWS + u.rt * 256) * 768); u.b = (const char*)(PIN + (size_t)u.g * 256 * 512); return true; }
    DI void gather(const Unit&, int, unsigned (&)[2][2]) const {}
    DI void epi(const g8::Acc& acc, const Unit& u, int wr, int wc, int fr, int fq) const {
#pragma unroll
        for (int ai = 0; ai < 2; ++ai)
#pragma unroll
            for (int m = 0; m < 4; ++m) {
                const int row = u.rt * 256 + ai * 128 + wr * 64 + m * 16 + fr;
                float* rowp = E + ((size_t)u.g * S5ROWS + row) * 256 + wc * 32 + fq * 8;
#pragma unroll
                for (int bj = 0; bj < 2; ++bj) { *(f32x4*)(rowp + bj * 128) = acc[ai][bj][m][0]; *(f32x4*)(rowp + bj * 128 + 4) = acc[ai][bj][m][1]; }
            }
    }
};
struct ProbS5Y {
    static constexpr bool GATHER = false;
    struct Unit { const char* a; const char* b; int g, rt, pn; };
    const bf16_t* UP; const bf16_t* M; bf16_t* YG; int G, vcu;
    static constexpr bool FP8 = false; DI int Kbytes() const { return 1536; } DI int ldaB() const { return 1536; } DI int ldbB() const { return 1536; } DI int kstepA() const { return 128; } DI int kstepB() const { return 128; }
    DI bool next(int i, Unit& u) const {
        const int L = i * G + vcu; if (L >= 64 * 5 * 2) return false;
        u.pn = L & 1; u.rt = (L >> 1) % 5; u.g = L / 10;
        u.a = (const char*)(UP + ((size_t)u.g * S5ROWS + u.rt * 256) * 768); u.b = (const char*)(M + ((size_t)u.g * 512 + u.pn * 256) * 768); return true; }
    DI void gather(const Unit&, int, unsigned (&)[2][2]) const {}
    DI void epi(const g8::Acc& acc, const Unit& u, int wr, int wc, int fr, int fq) const {
#pragma unroll
        for (int ai = 0; ai < 2; ++ai)
#pragma unroll
            for (int m = 0; m < 4; ++m) {
                const int cr = u.rt * 256 + ai * 128 + wr * 64 + m * 16 + fr;
                if (cr < S5VALID) {
                    const int tokbase = cr < 1024 ? (cr >> 8) * SEQ + (cr & 255) * S5T : TL + (cr - 1024) * S5T;
#pragma unroll
                    for (int bj = 0; bj < 2; ++bj) {
                        const int c = u.pn * 256 + bj * 128 + wc * 32 + fq * 8;
                        const int t = c >> 4, h0 = c & 15;
                        const f32x4 v0 = acc[ai][bj][m][0], v1 = acc[ai][bj][m][1];
                        u32x4 o; o[0] = cvt_pk_bf16(gelu_tanh(v0[0]), gelu_tanh(v0[1])); o[1] = cvt_pk_bf16(gelu_tanh(v0[2]), gelu_tanh(v0[3]));
                        o[2] = cvt_pk_bf16(gelu_tanh(v1[0]), gelu_tanh(v1[1])); o[3] = cvt_pk_bf16(gelu_tanh(v1[2]), gelu_tanh(v1[3]));
                        *(u32x4*)(YG + (size_t)(tokbase + t) * D + u.g * 16 + h0) = o;
                    }
                }
            }
    }
};
struct ProbGLU {
    static constexpr bool GATHER = false;
    struct Unit { const char* a; const char* b; int rt, pn; };
    const bf16_t* A; const bf16_t* W; bf16_t* H; const float* mod_g1_base;   int G, vcu;
    static constexpr bool FP8 = false; DI int Kbytes() const { return 2048; } DI int ldaB() const { return 2048; } DI int ldbB() const { return 2048; } DI int kstepA() const { return 128; } DI int kstepB() const { return 128; }
    DI bool next(int i, Unit& u) const {
        const int L = i * G + vcu; if (L >= (TT / 256) * 8) return false;
        u.pn = L & 7; u.rt = L >> 3;
        u.a = (const char*)(A + (size_t)u.rt * 256 * 1024); u.b = (const char*)(W + (size_t)u.pn * 256 * 1024); return true; }
    DI void gather(const Unit&, int, unsigned (&)[2][2]) const {}
    DI void epi(const g8::Acc& acc, const Unit& u, int wr, int wc, int fr, int fq) const {
        const int row0 = u.rt * 256; const int b = row0 < TL ? (row0 >> 13) : 4;
        const int c = u.pn * 128 + wc * 32 + fq * 8;
        const float* g1p = mod_g1_base + (size_t)b * 6144 + 2 * 1024 + c;
        const f32x4 g1a = *(const f32x4*)g1p, g1b = *(const f32x4*)(g1p + 4);
#pragma unroll
        for (int ai = 0; ai < 2; ++ai)
#pragma unroll
            for (int m = 0; m < 4; ++m) {
                const int row = row0 + ai * 128 + wr * 64 + m * 16 + fr;
                bf16_t* hp = H + (size_t)row * D + c;
                const u32x4 hv = *(const u32x4*)hp;
                f32x4 h0, h1; h0[0] = h_lo(hv[0]); h0[1] = h_hi(hv[0]); h0[2] = h_lo(hv[1]); h0[3] = h_hi(hv[1]); h1[0] = h_lo(hv[2]); h1[1] = h_hi(hv[2]); h1[2] = h_lo(hv[3]); h1[3] = h_hi(hv[3]);
                const f32x4 va = acc[ai][0][m][0], vb = acc[ai][0][m][1], ga = acc[ai][1][m][0], gb = acc[ai][1][m][1];
#pragma unroll
                for (int i = 0; i < 4; ++i) { h0[i] = DN_ALPHA * h0[i] + g1a[i] * (va[i] * sigmoidf_(ga[i])); h1[i] = DN_ALPHA * h1[i] + g1b[i] * (vb[i] * sigmoidf_(gb[i])); }
                u32x4 ho; ho[0] = cvt_pk_f16(h0[0], h0[1]); ho[1] = cvt_pk_f16(h0[2], h0[3]); ho[2] = cvt_pk_f16(h1[0], h1[1]); ho[3] = cvt_pk_f16(h1[2], h1[3]);
                *(u32x4*)hp = ho;
            }
    }
};
struct ProbProj {
    static constexpr bool GATHER = false;
    struct Unit { const char* a; const char* b; int rt, pn; };
    const bf16_t* A; const bf16_t* W; bf16_t* P; int G, vcu;
    static constexpr bool FP8 = false; DI int Kbytes() const { return 2048; } DI int ldaB() const { return 2048; } DI int ldbB() const { return 2048; } DI int kstepA() const { return 128; } DI int kstepB() const { return 128; }
    DI bool next(int i, Unit& u) const {
        const int L = i * G + vcu; if (L >= (TT / 256) * 12) return false;
        u.pn = L % 12; u.rt = L / 12;
        u.a = (const char*)(A + (size_t)u.rt * 256 * 1024); u.b = (const char*)(W + (size_t)u.pn * 256 * 1024); return true; }
    DI void gather(const Unit&, int, unsigned (&)[2][2]) const {}
    DI void epi(const g8::Acc& acc, const Unit& u, int wr, int wc, int fr, int fq) const {
#pragma unroll
        for (int ai = 0; ai < 2; ++ai)
#pragma unroll
            for (int m = 0; m < 4; ++m) {
                const int row = u.rt * 256 + ai * 128 + wr * 64 + m * 16 + fr;
#pragma unroll
                for (int bj = 0; bj < 2; ++bj) {
                    const int c = u.pn * 256 + bj * 128 + wc * 32 + fq * 8;
                    const f32x4 v0 = acc[ai][bj][m][0], v1 = acc[ai][bj][m][1];
                    u32x4 o; o[0] = cvt_pk_bf16(v0[0], v0[1]); o[1] = cvt_pk_bf16(v0[2], v0[3]); o[2] = cvt_pk_bf16(v1[0], v1[1]); o[3] = cvt_pk_bf16(v1[2], v1[3]);
                    *(u32x4*)(P + (size_t)row * 3072 + c) = o;
                }
            }
    }
};
struct ProbOut {
    static constexpr bool GATHER = false;
    struct Unit { const char* a; const char* b; int rt, pn; };
    const bf16_t* A; const bf16_t* W; bf16_t* H; const float* mod_g1_base; int nrt; int G, vcu;
    static constexpr bool FP8 = false; DI int Kbytes() const { return 2048; } DI int ldaB() const { return 2048; } DI int ldbB() const { return 2048; } DI int kstepA() const { return 128; } DI int kstepB() const { return 128; }
    DI bool next(int i, Unit& u) const {
        const int L = i * G + vcu; if (L >= nrt * 4) return false;
        u.pn = L & 3; u.rt = L >> 2;
        u.a = (const char*)(A + (size_t)u.rt * 256 * 1024); u.b = (const char*)(W + (size_t)u.pn * 256 * 1024); return true; }
    DI void gather(const Unit&, int, unsigned (&)[2][2]) const {}
    DI void epi(const g8::Acc& acc, const Unit& u, int wr, int wc, int fr, int fq) const {
        const int row0 = u.rt * 256; const int b = row0 < TL ? (row0 >> 13) : 4;
#pragma unroll
        for (int ai = 0; ai < 2; ++ai)
#pragma unroll
            for (int m = 0; m < 4; ++m) {
                const int r = row0 + ai * 128 + wr * 64 + m * 16 + fr;
                int tok = r;
                if (r < TL) { const int np = r & 8191; tok = (r & ~8191) + (np & 127) * 64 + (np >> 7); }
#pragma unroll
                for (int bj = 0; bj < 2; ++bj) {
                    const int c = u.pn * 256 + bj * 128 + wc * 32 + fq * 8;
                    const float* g1p = mod_g1_base + (size_t)b * 6144 + 2 * 1024 + c;
                    const f32x4 g1a = *(const f32x4*)g1p, g1b = *(const f32x4*)(g1p + 4);
                    bf16_t* hp = H + (size_t)tok * D + c;
                    const u32x4 hv = *(const u32x4*)hp;
                    f32x4 h0, h1; h0[0] = h_lo(hv[0]); h0[1] = h_hi(hv[0]); h0[2] = h_lo(hv[1]); h0[3] = h_hi(hv[1]); h1[0] = h_lo(hv[2]); h1[1] = h_hi(hv[2]); h1[2] = h_lo(hv[3]); h1[3] = h_hi(hv[3]);
                    const f32x4 va = acc[ai][bj][m][0], vb = acc[ai][bj][m][1];
#pragma unroll
                    for (int i = 0; i < 4; ++i) { h0[i] = DN_ALPHA * h0[i] + g1a[i] * va[i]; h1[i] = DN_ALPHA * h1[i] + g1b[i] * vb[i]; }
                    u32x4 ho; ho[0] = cvt_pk_f16(h0[0], h0[1]); ho[1] = cvt_pk_f16(h0[2], h0[3]); ho[2] = cvt_pk_f16(h1[0], h1[1]); ho[3] = cvt_pk_f16(h1[2], h1[3]);
                    *(u32x4*)hp = ho;
                }
            }
    }
};
struct MoeTab { const LAS int* t; DI int cnt(int e) const { return t[e]; } DI int tpre(int e) const { return t[32 + e]; } DI int tile_e(int T) const { return ((const LAS unsigned char*)(t + 80))[T]; } };
struct ProbUp {
    static constexpr bool GATHER = true, FP8 = true;
    struct Unit { const char* a; const char* b; int e, rt, pn, cnt, prow; };
    const unsigned char* UB8; const unsigned char* W;   const float* bup;   const int* TOKL; unsigned char* ACT; MoeTab tab; int G, vcu; int dry;
    DI int Kbytes() const { return 1024; } DI int ldaB() const { return 128; } DI int ldbB() const { return 128; } DI int kstepA() const { return TT * 128; } DI int kstepB() const { return 2048 * 128; }
    DI bool next(int i, Unit& u) const {
        int e, rt, pn, tp;
        {
            const int L = i * G + vcu; const int T = L >> 3;
            if (T >= tab.tpre(32)) return false;
            e = tab.tile_e(T);
            tp = tab.tpre(e); rt = T - tp; pn = L & 7;
        }
        e = __builtin_amdgcn_readfirstlane(e); tp = __builtin_amdgcn_readfirstlane(tp); rt = __builtin_amdgcn_readfirstlane(rt); pn = __builtin_amdgcn_readfirstlane(pn);
        u.e = e; u.rt = rt; u.pn = pn; u.cnt = __builtin_amdgcn_readfirstlane(tab.cnt(e)); u.prow = (tp + rt) * 256;
        u.a = (const char*)UB8; u.b = (const char*)(W + (size_t)e * 2048 * 1024 + (size_t)pn * 256 * 128); return true; }
    DI void gather(const Unit& u, int tid, unsigned (&vo)[2][2]) const {
#pragma unroll
        for (int i = 0; i < 2; ++i) { int R, C; g8::stage_rc(tid * 16 + i * 8192, R, C);
#pragma unroll
            for (int h = 0; h < 2; ++h) { const int slot = u.rt * 256 + R + h * 128;
                const int tk = slot < u.cnt ? TOKL[(size_t)u.e * TT + slot] : 0;
                vo[h][i] = (unsigned)(tk >> 2) * 128u + (unsigned)C * 2u; } }
    }
    DI void epi(const g8::Acc& acc, const Unit& u, int wr, int wc, int fr, int fq) const {
        if (dry) return;
        const int c = u.pn * 128 + wc * 32 + fq * 8;
        const float* bp = bup + (size_t)u.e * 2048 + c;
        const f32x4 bga = *(const f32x4*)bp, bgb = *(const f32x4*)(bp + 4), bla = *(const f32x4*)(bp + 1024), blb = *(const f32x4*)(bp + 1028);
#pragma unroll
        for (int ai = 0; ai < 2; ++ai)
#pragma unroll
            for (int m = 0; m < 4; ++m) {
                const int r = ai * 128 + wr * 64 + m * 16 + fr;
                const f32x4 va = acc[ai][0][m][0] * 0.03125f + bga, vb = acc[ai][0][m][1] * 0.03125f + bgb, la = acc[ai][1][m][0] * 0.03125f + bla, lb = acc[ai][1][m][1] * 0.03125f + blb;
                float o[8];
#pragma unroll
                for (int i = 0; i < 4; ++i) {
                    const float g0 = fminf(va[i], 7.0f), l0 = fminf(fmaxf(la[i], -7.0f), 7.0f); o[i] = 4.0f * g0 * sigmoidf_(1.702f * g0) * (l0 + 1.0f);
                    const float g1 = fminf(vb[i], 7.0f), l1 = fminf(fmaxf(lb[i], -7.0f), 7.0f); o[4 + i] = 4.0f * g1 * sigmoidf_(1.702f * g1) * (l1 + 1.0f); }
                u32x2 ov; ov[0] = pack_fp8x4(o[0], o[1], o[2], o[3]); ov[1] = pack_fp8x4(o[4], o[5], o[6], o[7]);
                *(u32x2*)(ACT + ((size_t)u.pn * ACT_ROWS + u.prow + r) * 128 + wc * 32 + fq * 8) = ov;
            }
    }
};
struct ProbDown {
    static constexpr bool GATHER = false, FP8 = true;
    struct Unit { const char* a; const char* b; int e, rt, pn, cnt; };
    const unsigned char* ACT; const unsigned char* W; const float* bdn;   const int* TOKL; const float* GATEL; bf16_t* FEXP; MoeTab tab; int G, vcu; int dry;
    DI int Kbytes() const { return 1024; } DI int ldaB() const { return 128; } DI int ldbB() const { return 128; } DI int kstepA() const { return ACT_ROWS * 128; } DI int kstepB() const { return 1024 * 128; }
    DI bool next(int i, Unit& u) const {
        int e, rt, pn, tp;
        {
            const int L = i * G + vcu; const int T = L >> 2;
            if (T >= tab.tpre(32)) return false;
            e = tab.tile_e(T);
            tp = tab.tpre(e); rt = T - tp; pn = L & 3;
        }
        e = __builtin_amdgcn_readfirstlane(e); tp = __builtin_amdgcn_readfirstlane(tp); rt = __builtin_amdgcn_readfirstlane(rt); pn = __builtin_amdgcn_readfirstlane(pn);
        u.e = e; u.rt = rt; u.pn = pn; u.cnt = __builtin_amdgcn_readfirstlane(tab.cnt(e));
        u.a = (const char*)(ACT + (size_t)(tp + rt) * 256 * 128); u.b = (const char*)(W + (size_t)e * 1024 * 1024 + (size_t)pn * 256 * 128); return true; }
    DI void gather(const Unit&, int, unsigned (&)[2][2]) const {}
    DI void epi(const g8::Acc& acc, const Unit& u, int wr, int wc, int fr, int fq) const {
        if (dry) return;
#pragma unroll
        for (int ai = 0; ai < 2; ++ai)
#pragma unroll
            for (int m = 0; m < 4; ++m) {
                const int slot = u.rt * 256 + ai * 128 + wr * 64 + m * 16 + fr;
                if (slot < u.cnt) {
                    const int tk = TOKL[(size_t)u.e * TT + slot]; const float gt = GATEL[(size_t)u.e * TT + slot];
#pragma unroll
                    for (int bj = 0; bj < 2; ++bj) {
                        const int c = u.pn * 256 + bj * 128 + wc * 32 + fq * 8;
                        const float* bp = bdn + (size_t)u.e * 1024 + c;
                        const f32x4 ba = *(const f32x4*)bp, bb = *(const f32x4*)(bp + 4);
                        const f32x4 va = (acc[ai][bj][m][0] * 0.00390625f + ba) * gt, vb = (acc[ai][bj][m][1] * 0.00390625f + bb) * gt;
                        u32x4 o; o[0] = cvt_pk_bf16(va[0], va[1]); o[1] = cvt_pk_bf16(va[2], va[3]); o[2] = cvt_pk_bf16(vb[0], vb[1]); o[3] = cvt_pk_bf16(vb[2], vb[3]);
                        *(u32x4*)(FEXP + (size_t)tk * D + c) = o;
                    }
                }
            }
    }
};
enum { IN_INIT = 0, IN_LN = 1, IN_COMBINE = 2 };
enum { OUT_S5 = 0, OUT_CMLR = 1, OUT_ROUTER = 2, OUT_FINAL = 3 };
constexpr int RP_TSTR = 2064;
constexpr int RP_TILE = 0;
constexpr int RP_RED = 66048;
constexpr int RP_LOGIT = RP_RED + 33792;
constexpr int RP_ENT_TK = RP_LOGIT + 4224;
constexpr int RP_ENT_GATE = RP_ENT_TK + 8192;
constexpr int RP_ENT_ER = RP_ENT_GATE + 8192;
constexpr int RP_HIST = RP_ENT_ER + 8192;
constexpr int RP_BASE = RP_HIST + 128;
static_assert(RP_BASE + 128 <= LDS_MISC, "row-pass LDS map");

DI int cm_row(int row) { if (row < TL) { const int l = row & 8191; return (row & ~8191) + (l & 63) * 128 + (l >> 6); } return row; }

template <int INM, int OUTM>
DI void row_pass(const Frame& F, int nrows, int mod_layer_in  , const float* ln_g, const float* ln_b,
                 int mod_layer_out, int mod_sh  , const bf16_t* Wt  , const float* wbias  ,
                 int moe_layer) {
    bf16_t* H = (bf16_t*)(F.ws + WS_H);
    bf16_t* UB = (bf16_t*)(F.ws + WS_UB);
    bf16_t* UP = (bf16_t*)(F.ws + WS_UP);
    unsigned char* UB8 = F.ws + WS_UB8;
    const bf16_t* FEXP = (const bf16_t*)(F.ws + WS_FEXP);
    float* ALR = (float*)(F.ws + WS_ALR);
    LAS unsigned char* lds = F.lds;
    LAS int* hist = (LAS int*)(lds + RP_HIST);
    LAS int* basev = (LAS int*)(lds + RP_BASE);
    LAS int* ent_tk = (LAS int*)(lds + RP_ENT_TK); LAS float* ent_gate = (LAS float*)(lds + RP_ENT_GATE); LAS int* ent_er = (LAS int*)(lds + RP_ENT_ER);
    const int lane = F.lane, w = F.wave, tid = F.tid;
    if (OUTM == OUT_ROUTER) { if (tid < 32) hist[tid] = 0; }
    __syncthreads();
    const int ntiles = nrows / 32;
    int titer = 0;
    for (int tt = F.vcu; tt < ntiles; tt += F.G, ++titer) {
        const int row0 = tt * 32;
        const int b = row0 < TL ? (row0 >> 13) : 4;
        f32x4 lg[4], lb[4], msc[4], msh[4], mg2[4];
#pragma unroll
        for (int i = 0; i < 4; ++i) {
            const int c = 256 * i + 4 * lane;
            if (INM != IN_INIT) { lg[i] = *(const f32x4*)(ln_g + c); lb[i] = *(const f32x4*)(ln_b + c); }
            if (INM == IN_COMBINE) mg2[i] = *(const f32x4*)(modp(F, mod_layer_in, b, 5) + c);
            if (OUTM != OUT_FINAL) { msh[i] = *(const f32x4*)(modp(F, mod_layer_out, b, mod_sh) + c); msc[i] = *(const f32x4*)(modp(F, mod_layer_out, b, mod_sh + 1) + c); }
        }
#pragma unroll 1
        for (int rr = 0; rr < 4; ++rr) {
            const int rl = 4 * w + rr, row = row0 + rl;
            f32x4 v[4];
            if (INM == IN_INIT) {
                const float* src = row < TL ? F.inp(I_X) + (size_t)row * D : F.inp(I_CTX) + (size_t)(row - TL) * D;
#pragma unroll
                for (int i = 0; i < 4; ++i) v[i] = *(const f32x4*)(src + 256 * i + 4 * lane);
            } else {
#pragma unroll
                for (int i = 0; i < 4; ++i) { const u32x2 hv = *(const u32x2*)(H + (size_t)row * D + 256 * i + 4 * lane); v[i][0] = h_lo(hv[0]); v[i][1] = h_hi(hv[0]); v[i][2] = h_lo(hv[1]); v[i][3] = h_hi(hv[1]); }
            }
            if (INM == IN_COMBINE) {
#pragma unroll
                for (int i = 0; i < 4; ++i) {
                    f32x4 f = (f32x4){0.f, 0.f, 0.f, 0.f};
#pragma unroll
                    for (int k = 0; k < 4; ++k) {
                        const u32x2 p = *(const u32x2*)(FEXP + ((size_t)row * 4 + k) * D + 256 * i + 4 * lane);
                        f[0] += bf_lo(p[0]); f[1] += bf_hi(p[0]); f[2] += bf_lo(p[1]); f[3] += bf_hi(p[1]);
                    }
                    v[i] = DN_ALPHA * v[i] + mg2[i] * f;
                }
            }
            if (INM != IN_INIT) {
                float s = 0.f;
#pragma unroll
                for (int i = 0; i < 4; ++i) s += v[i][0] + v[i][1] + v[i][2] + v[i][3];
                const float mean = wave_sum(s) * (1.0f / 1024.0f);
                float q = 0.f;
#pragma unroll
                for (int i = 0; i < 4; ++i) { v[i] = v[i] - mean; q += v[i][0] * v[i][0] + v[i][1] * v[i][1] + v[i][2] * v[i][2] + v[i][3] * v[i][3]; }
                const float rstd = rsqrtf(wave_sum(q) * (1.0f / 1024.0f) + LN_EPS);
#pragma unroll
                for (int i = 0; i < 4; ++i) v[i] = v[i] * rstd * lg[i] + lb[i];
            }
            if (OUTM == OUT_FINAL) {
#pragma unroll
                for (int i = 0; i < 4; ++i) *(f32x4*)(F.out + (size_t)row * D + 256 * i + 4 * lane) = v[i];
            } else {
#pragma unroll
                for (int i = 0; i < 4; ++i) { u32x2 hv; hv[0] = cvt_pk_f16(v[i][0], v[i][1]); hv[1] = cvt_pk_f16(v[i][2], v[i][3]); *(u32x2*)(H + (size_t)row * D + 256 * i + 4 * lane) = hv; }
                const int drow = (OUTM == OUT_CMLR) ? cm_row(row) : row;
#pragma unroll
                for (int i = 0; i < 4; ++i) {
                    const f32x4 u = v[i] * (msc[i] + 1.0f) + msh[i];
                    u32x2 p; p[0] = cvt_pk_bf16(u[0], u[1]); p[1] = cvt_pk_bf16(u[2], u[3]);
                    *(LAS u32x2*)(lds + RP_TILE + rl * RP_TSTR + (256 * i + 4 * lane) * 2) = p;
                    if (OUTM == OUT_CMLR) *(u32x2*)(UB + (size_t)drow * D + 256 * i + 4 * lane) = p;
                    if (OUTM == OUT_ROUTER) *(unsigned*)(UB8 + ((size_t)(2 * i + (lane >> 5)) * TT + drow) * 128 + ((4 * lane) & 127)) = pack_fp8x4(u[0], u[1], u[2], u[3]);
                }
            }
        }
        if (OUTM == OUT_FINAL) continue;
        __syncthreads();
        if (OUTM == OUT_S5) {
            const int t = lane >> 1, half = lane & 1;
#pragma unroll
            for (int gg = 0; gg < 8; ++gg) {
                const int g = w * 8 + gg;
                const u32x4 p = *(const LAS u32x4*)(lds + RP_TILE + t * RP_TSTR + (g * 16 + half * 8) * 2);
                *(u32x4*)(UP + ((size_t)g * S5ROWS + tt) * 768 + t * 16 + half * 8) = p;
            }
        } else {
            f32x16 acc;
#pragma unroll
            for (int i = 0; i < 16; ++i) acc[i] = 0.f;
            const int r = lane & 31, hh = lane >> 5;
#pragma unroll
            for (int s = 0; s < 8; ++s) {
                const int k0 = 128 * w + 16 * s + 8 * hh;
                const bf16x8 a = *(const LAS bf16x8*)(lds + RP_TILE + r * RP_TSTR + k0 * 2);
                const bf16x8 bb = *(const bf16x8*)(Wt + (size_t)r * D + k0);
                acc = __builtin_amdgcn_mfma_f32_32x32x16_bf16(a, bb, acc, 0, 0, 0);
            }
            LAS float* red = (LAS float*)(lds + RP_RED) + w * (32 * 33);
#pragma unroll
            for (int i = 0; i < 16; ++i) { const int xr = (i & 3) + 8 * (i >> 2) + 4 * hh; red[xr * 33 + r] = acc[i]; }
            __syncthreads();
            LAS float* logit = (LAS float*)(lds + RP_LOGIT);
#pragma unroll
            for (int q = 0; q < 2; ++q) {
                const int idx = tid + 512 * q, xr = idx >> 5, xc = idx & 31;
                float s = wbias ? wbias[xc] : 0.f;
#pragma unroll
                for (int ww = 0; ww < 8; ++ww) s += ((LAS float*)(lds + RP_RED))[ww * (32 * 33) + xr * 33 + xc];
                if (OUTM == OUT_CMLR) ALR[(size_t)cm_row(row0 + xr) * 32 + xc] = s;
                else logit[xr * 33 + xc] = s;
            }
            if (OUTM == OUT_ROUTER) {
                __syncthreads();
                if (tid < 32) {
                    float lv[32];
#pragma unroll
                    for (int e = 0; e < 32; ++e) lv[e] = logit[tid * 33 + e];
                    unsigned taken = 0u; float tv[4]; int ti[4];
#pragma unroll
                    for (int k = 0; k < 4; ++k) {
                        float best = -3.0e38f; int bi = 0;
#pragma unroll
                        for (int e = 0; e < 32; ++e) { const bool ok = !((taken >> e) & 1u) && (lv[e] > best); best = ok ? lv[e] : best; bi = ok ? e : bi; }
                        taken |= 1u << bi; tv[k] = best; ti[k] = bi;
                    }
                    float ex[4], se = 0.f;
#pragma unroll
                    for (int k = 0; k < 4; ++k) { ex[k] = __expf(tv[k] - tv[0]); se += ex[k]; }
                    const float inv = 1.0f / se;
#pragma unroll
                    for (int k = 0; k < 4; ++k) {
                        const int rank = __hip_atomic_fetch_add(&hist[ti[k]], 1, __ATOMIC_RELAXED, __HIP_MEMORY_SCOPE_WORKGROUP);
                        const int n = titer * 128 + tid * 4 + k;
                        ent_tk[n] = (row0 + tid) * 4 + k; ent_gate[n] = ex[k] * inv; ent_er[n] = (ti[k] << 16) | rank;
                    }
                }
            }
        }
        __syncthreads();
    }
    if (OUTM == OUT_ROUTER) {
        __syncthreads();
        unsigned* CNT = (unsigned*)(F.ws + WS_CTL) + CW_CNT + moe_layer * 32;
        if (tid < 32) basev[tid] = (int)__hip_atomic_fetch_add(&CNT[tid], (unsigned)hist[tid], __ATOMIC_RELAXED, __HIP_MEMORY_SCOPE_AGENT);
        __syncthreads();
        int* TOKL = (int*)(F.ws + WS_TOKL); float* GATEL = (float*)(F.ws + WS_GATEL);
        const int nent = titer * 128;
        for (int n = tid; n < nent; n += NTHR) {
            const int er = ent_er[n], e = er >> 16, slot = basev[e] + (er & 0xffff);
            TOKL[(size_t)e * TT + slot] = ent_tk[n]; GATEL[(size_t)e * TT + slot] = ent_gate[n];
        }
    }
}

constexpr int PC_A = 0;
constexpr int PC_BB = 33792;
constexpr int PC_C = PC_BB + 16384;
constexpr int PC_K = PC_C + 16384;
static_assert(PC_K + 65536 <= LDS_MISC, "precompute LDS map");
typedef float cf __attribute__((ext_vector_type(2)));
DI cf mkcf(float x, float y) { cf r; r.x = x; r.y = y; return r; }
DI cf cmul(cf a, cf b) { return mkcf(a.x * b.x - a.y * b.y, a.x * b.y + a.y * b.x); }

DI void s5_precompute(const Frame& F, int j, int g) {
    LAS cf* PA = (LAS cf*)(F.lds + PC_A); LAS cf* PB = (LAS cf*)(F.lds + PC_BB); LAS cf* PCc = (LAS cf*)(F.lds + PC_C); LAS float* PK = (LAS float*)(F.lds + PC_K);
    const int tid = F.tid;
    __syncthreads();
    if (tid < 128) {
        const int dir = tid >> 6, p = tid & 63;
        const size_t gp = ((size_t)(j * 2 + dir) * 64 + g) * 64 + p;
        const float lr = F.inp(I_LAMRE)[gp], li = F.inp(I_LAMIM)[gp];
        const float dt = expf(F.inp(I_LOGSTEP)[(size_t)(j * 2 + dir) * 64 + g]);
        const float mag = expf(lr * dt); float sn, cs; sincosf(li * dt, &sn, &cs);
        const cf a = mkcf(mag * cs, mag * sn);
        const float den = lr * lr + li * li; const float nr = a.x - 1.0f;
        const cf kf = mkcf((nr * lr + a.y * li) / den, (a.y * lr - nr * li) / den);
        cf pw = mkcf(1.0f, 0.0f);
        for (int n = 0; n <= 32; ++n) { PA[(dir * 33 + n) * 64 + p] = pw; pw = cmul(pw, a); }
        for (int h = 0; h < 16; ++h) { const cf bb = mkcf(F.inp(I_BRE)[gp * 16 + h], F.inp(I_BIM)[gp * 16 + h]); PB[(dir * 64 + p) * 16 + h] = cmul(kf, bb); }
        for (int h = 0; h < 16; ++h) { const size_t ci = (((size_t)(j * 2 + dir) * 64 + g) * 16 + h) * 64 + p; PCc[(dir * 16 + h) * 64 + p] = mkcf(F.inp(I_CRE)[ci], F.inp(I_CIM)[ci]); }
    }
    __syncthreads();
    for (int idx = tid; idx < 2 * 32 * 256; idx += NTHR) {
        const int h = idx & 15, hp = (idx >> 4) & 15, tau = (idx >> 8) & 31, dir = idx >> 13;
        float s = 0.f;
        for (int p = 0; p < 64; ++p) { const cf c = PCc[(dir * 16 + hp) * 64 + p], a = PA[(dir * 33 + tau) * 64 + p], bb = PB[(dir * 64 + p) * 16 + h]; const cf ca = cmul(c, a); s += ca.x * bb.x - ca.y * bb.y; }
        PK[idx] = s;
    }
    __syncthreads();
    bf16_t* M = (bf16_t*)(F.ws + WS_S5M) + (size_t)(j * 64 + g) * 512 * 768;
    const float* dsk = F.inp(I_S5D) + (size_t)j * D + g * 16;
    for (int idx = tid; idx < 512 * 768; idx += NTHR) {
        const int rho = idx / 768, kc = idx % 768;
        const int o = (rho & ~31) + perm32(rho & 31);
        const int t = o >> 4, hp = o & 15;
        float val;
        if (kc < 512) {
            const int jj = kc >> 4, h = kc & 15;
            val = 0.f;
            if (jj <= t) val += PK[((0 * 32 + (t - jj)) * 16 + hp) * 16 + h];
            if (jj >= t) val += PK[((1 * 32 + (jj - t)) * 16 + hp) * 16 + h];
            if (jj == t && h == hp) val += dsk[hp];
        } else {
            const int s = kc - 512, dir = s >> 7, im = (s >> 6) & 1, p = s & 63;
            const int n = dir == 0 ? t + 1 : 32 - t;
            const cf z = cmul(PCc[(dir * 16 + hp) * 64 + p], PA[(dir * 33 + n) * 64 + p]);
            val = im ? -z.y : z.x;
        }
        M[idx] = f2bf(val);
    }
    bf16_t* PIN = (bf16_t*)(F.ws + WS_S5PIN) + (size_t)(j * 64 + g) * 256 * 512;
    for (int idx = tid; idx < 256 * 512; idx += NTHR) {
        const int rho = idx >> 9, kc = idx & 511;
        const int s = (rho & ~31) + perm32(rho & 31);
        const int dir = s >> 7, im = (s >> 6) & 1, p = s & 63;
        const int jj = kc >> 4, h = kc & 15;
        const int n = dir == 0 ? 31 - jj : jj;
        const cf x = cmul(PA[(dir * 33 + n) * 64 + p], PB[(dir * 64 + p) * 16 + h]);
        PIN[idx] = f2bf(im ? x.y : x.x);
    }
    if (tid < 128) { const int dir = tid >> 6, p = tid & 63; const cf aT = PA[(dir * 33 + 32) * 64 + p];
        float* AT = (float*)(F.ws + WS_S5AT) + (((size_t)(j * 64 + g) * 2 + dir) * 64 + p) * 2; AT[0] = aT.x; AT[1] = aT.y; }
}

DI void mod_item(const Frame& F, int layer, int nblk) {
    LAS float* cond = (LAS float*)(F.lds);
    LAS float* red = (LAS float*)(F.lds + 20480);
    const int tid = F.tid;
    __syncthreads();
    for (int idx = tid; idx < 5 * 1024; idx += NTHR) { const int r = idx >> 10, k = idx & 1023; const float c = r < 4 ? F.inp(I_C)[r * 1024 + k] : F.inp(I_CCTX)[k]; cond[idx] = c / (1.0f + __expf(-c)); }
    __syncthreads();
    const int cq = tid & 31, kg = tid >> 5, n0 = nblk * 128;
    const float* W = F.inp(I_WADA) + (size_t)layer * 1024 * 6144 + n0 + cq * 4;
    f32x4 acc[5];
#pragma unroll
    for (int r = 0; r < 5; ++r) acc[r] = (f32x4){0.f, 0.f, 0.f, 0.f};
#pragma unroll 8
    for (int kk = 0; kk < 64; ++kk) {
        const int k = kg * 64 + kk;
        const f32x4 wv = *(const f32x4*)(W + (size_t)k * 6144);
#pragma unroll
        for (int r = 0; r < 5; ++r) acc[r] += cond[r * 1024 + k] * wv;
    }
#pragma unroll
    for (int r = 0; r < 5; ++r)
#pragma unroll
        for (int i = 0; i < 4; ++i) red[(kg * 5 + r) * 128 + cq * 4 + i] = acc[r][i];
    __syncthreads();
    for (int idx = tid; idx < 5 * 128; idx += NTHR) {
        const int r = idx >> 7, n = idx & 127;
        float s = F.inp(I_BADA)[(size_t)layer * 6144 + n0 + n];
        for (int q = 0; q < 16; ++q) s += red[(q * 5 + r) * 128 + n];
        ((float*)(F.ws + WS_MOD))[(size_t)(layer * 5 + r) * 6144 + n0 + n] = s;
    }
}

DI int phys_row(int n, int mode) {
    if (mode == 0) return (n & ~31) + inv32(n & 31);
    const int half = n >> 10, jn = n & 1023;
    return 256 * (jn >> 7) + 128 * half + 32 * ((jn & 127) >> 5) + inv32(jn & 31);
}
DI void transpose_tile(const Frame& F, const float* src, int ld, bf16_t* dst, int mode, int kt, int ntile) {
    LAS bf16_t* T = (LAS bf16_t*)F.lds;
    const int tid = F.tid, k0 = kt * 128, n0 = ntile * 128;
    __syncthreads();
#pragma unroll
    for (int q = 0; q < 8; ++q) {
        const int idx = tid + 512 * q, kr = idx >> 5, c4 = idx & 31;
        const f32x4 v = *(const f32x4*)(src + (size_t)(k0 + kr) * ld + n0 + c4 * 4);
#pragma unroll
        for (int i = 0; i < 4; ++i) T[(c4 * 4 + i) * 136 + kr] = f2bf(v[i]);
    }
    __syncthreads();
#pragma unroll
    for (int q = 0; q < 4; ++q) {
        const int idx = tid + 512 * q, nl = idx >> 4, ch = idx & 15;
        const u32x4 p = *(const LAS u32x4*)(T + nl * 136 + ch * 8);
        *(u32x4*)(dst + (size_t)phys_row(n0 + nl, mode) * 1024 + k0 + ch * 8) = p;
    }
}
DI void transpose_tile8(const Frame& F, const float* src, int ld, unsigned char* dst, int nrows, int mode, int kt, int ntile, float scale) {
    LAS unsigned char* T = F.lds;
    const int tid = F.tid, k0 = kt * 128, n0 = ntile * 128;
    __syncthreads();
#pragma unroll
    for (int q = 0; q < 2; ++q) {
        const int task = tid + 512 * q, k4 = task >> 5, c4 = task & 31;
        f32x4 v[4];
#pragma unroll
        for (int r = 0; r < 4; ++r) v[r] = *(const f32x4*)(src + (size_t)(k0 + k4 * 4 + r) * ld + n0 + c4 * 4) * scale;
#pragma unroll
        for (int i = 0; i < 4; ++i) *(LAS unsigned*)(T + (c4 * 4 + i) * 144 + k4 * 4) = pack_fp8x4(v[0][i], v[1][i], v[2][i], v[3][i]);
    }
    __syncthreads();
#pragma unroll
    for (int q = 0; q < 2; ++q) {
        const int idx = tid + 512 * q, nl = idx >> 3, ch = idx & 7;
        const u32x4 p = *(const LAS u32x4*)(T + nl * 144 + ch * 16);
        *(u32x4*)(dst + ((size_t)kt * nrows + phys_row(n0 + nl, mode)) * 128 + ch * 16) = p;
    }
}
DI void small_transpose(const Frame& F, const float* src, int ld, int c0, bf16_t* dst) {
    for (int idx = F.tid; idx < 32 * 1024; idx += NTHR) { const int e = idx >> 10, k = idx & 1023; dst[idx] = f2bf(src[(size_t)k * ld + c0 + e]); }
}

struct TJob { const float* src; unsigned char* dst; int ld, nrows, mode, kt, ntile, fp8; float scale; };
constexpr int PI_S5 = 128, PI_MOD = 192, PI_GLU = 2 * 128, PI_WIN = 2 * 192, PI_WOUT = 2 * 64, PI_UP = 128 * 128, PI_DN = 128 * 64, PI_SMALL = 6;
constexpr int PI_TOTAL = PI_S5 + PI_MOD + PI_GLU + PI_WIN + PI_WOUT + PI_UP + PI_DN + PI_SMALL;
DI void prologue_item(const Frame& F, int it) {
    if (it < PI_S5) { s5_precompute(F, it >> 6, it & 63); return; } it -= PI_S5;
    mod_item(F, it / 48, it % 48);
}
DI bool tjob_decode(const Frame& F, int it, TJob& J) {
    J.scale = 1.0f; J.fp8 = 0;
    if (it < PI_GLU) { const int j = it >> 7, r = it & 127; J.src = F.inp(I_WGLU) + (size_t)j * 1024 * 2048; J.ld = 2048; J.dst = F.ws + WS_WGLU + (size_t)j * 2048 * 1024 * 2; J.nrows = 2048; J.mode = 1; J.kt = r >> 4; J.ntile = r & 15; return true; } it -= PI_GLU;
    if (it < PI_WIN) { const int j = it / 192, r = it % 192; J.src = F.inp(I_WIN) + (size_t)j * 1024 * 3104; J.ld = 3104; J.dst = F.ws + WS_WIN + (size_t)j * 3072 * 1024 * 2; J.nrows = 3072; J.mode = 0; J.kt = r / 24; J.ntile = r % 24; return true; } it -= PI_WIN;
    if (it < PI_WOUT) { const int j = it >> 6, r = it & 63; J.src = F.inp(I_WOUT) + (size_t)j * 1024 * 1024; J.ld = 1024; J.dst = F.ws + WS_WOUT + (size_t)j * 1024 * 1024 * 2; J.nrows = 1024; J.mode = 0; J.kt = r >> 3; J.ntile = r & 7; return true; } it -= PI_WOUT;
    if (it < PI_UP) { const int le = it >> 7, r = it & 127; J.src = F.inp(I_WUP) + (size_t)le * 1024 * 2048; J.ld = 2048; J.dst = F.ws + WS_WUP + (size_t)le * 2048 * 1024; J.nrows = 2048; J.mode = 1; J.kt = r >> 4; J.ntile = r & 15; J.fp8 = 1; J.scale = 32.0f; return true; } it -= PI_UP;
    if (it < PI_DN) { const int le = it >> 6, r = it & 63; J.src = F.inp(I_WDN) + (size_t)le * 1024 * 1024; J.ld = 1024; J.dst = F.ws + WS_WDN + (size_t)le * 1024 * 1024; J.nrows = 1024; J.mode = 0; J.kt = r >> 3; J.ntile = r & 7; J.fp8 = 1; J.scale = 64.0f; return true; } it -= PI_DN;
    if (it < 4) small_transpose(F, F.inp(I_WROUTER) + (size_t)it * 1024 * 32, 32, 0, (bf16_t*)(F.ws + WS_WR) + (size_t)it * 32 * 1024);
    else small_transpose(F, F.inp(I_WIN) + (size_t)(it - 4) * 1024 * 3104, 3104, 3072, (bf16_t*)(F.ws + WS_WLR) + (size_t)(it - 4) * 32 * 1024);
    return false;
}
DI void tjob_load(const TJob& J, int tid, f32x4 (&v)[2][4]) {
#pragma unroll
    for (int q = 0; q < 2; ++q) { const int task = tid + 512 * q, k4 = task >> 5, c4 = task & 31;
#pragma unroll
        for (int r = 0; r < 4; ++r) v[q][r] = *(const f32x4*)(J.src + (size_t)(J.kt * 128 + k4 * 4 + r) * J.ld + J.ntile * 128 + c4 * 4); }
}
DI void tjob_to_lds(const Frame& F, const TJob& J, int tid, const f32x4 (&v)[2][4]) {
    LAS unsigned char* T = F.lds;
#pragma unroll
    for (int q = 0; q < 2; ++q) { const int task = tid + 512 * q, k4 = task >> 5, c4 = task & 31;
#pragma unroll
        for (int i = 0; i < 4; ++i) {
            if (J.fp8) *(LAS unsigned*)(T + (c4 * 4 + i) * 144 + k4 * 4) = pack_fp8x4(v[q][0][i] * J.scale, v[q][1][i] * J.scale, v[q][2][i] * J.scale, v[q][3][i] * J.scale);
            else { u32x2 p; p[0] = cvt_pk_bf16(v[q][0][i], v[q][1][i]); p[1] = cvt_pk_bf16(v[q][2][i], v[q][3][i]); *(LAS u32x2*)(T + (c4 * 4 + i) * 272 + k4 * 8) = p; }
        } }
}
DI void tjob_store(const Frame& F, const TJob& J, int tid) {
    const LAS unsigned char* T = F.lds;
    const int n0 = J.ntile * 128;
    if (J.fp8) {
#pragma unroll
        for (int q = 0; q < 2; ++q) { const int idx = tid + 512 * q, nl = idx >> 3, ch = idx & 7;
            *(u32x4*)(J.dst + ((size_t)J.kt * J.nrows + phys_row(n0 + nl, J.mode)) * 128 + ch * 16) = *(const LAS u32x4*)(T + nl * 144 + ch * 16); }
    } else {
#pragma unroll
        for (int q = 0; q < 4; ++q) { const int idx = tid + 512 * q, nl = idx >> 4, ch = idx & 15;
            *(u32x4*)(J.dst + ((size_t)phys_row(n0 + nl, J.mode) * 1024 + J.kt * 128) * 2 + ch * 16) = *(const LAS u32x4*)(T + nl * 272 + ch * 16); }
    }
}
DI void transpose_batch(const Frame& F, int first, int count) {
    f32x4 va[2][4], vb[2][4]; TJob Ja, Jb, Jn; bool ha = false, hb = false;
    int it = first; const int end = first + count;
    while (it < end && !ha) { ha = tjob_decode(F, it, Ja); ++it; }
    if (ha) tjob_load(Ja, F.tid, va);
    while (it < end && !hb) { hb = tjob_decode(F, it, Jb); ++it; }
    if (hb) tjob_load(Jb, F.tid, vb);
#define TB_PROCESS(J, h, v) do { __syncthreads(); tjob_to_lds(F, J, F.tid, v); bool hn = false; \
        while (it < end && !hn) { hn = tjob_decode(F, it, Jn); ++it; } \
        if (hn) tjob_load(Jn, F.tid, v); \
        __syncthreads(); tjob_store(F, J, F.tid); J = Jn; h = hn; } while (0)
    while (ha || hb) {
        if (ha) TB_PROCESS(Ja, ha, va);
        if (hb) TB_PROCESS(Jb, hb, vb);
    }
#undef TB_PROCESS
}

DI void s5_scan(const Frame& F, int j) {
    const float* E = (const float*)(F.ws + WS_E);
    bf16_t* UP = (bf16_t*)(F.ws + WS_UP);
    const float* AT = (const float*)(F.ws + WS_S5AT);
    const int sub = F.tid >> 7, t7 = F.tid & 127, dir = t7 >> 6, p = t7 & 63;
    for (int item = F.vcu + F.G * sub; item < 256; item += 4 * F.G) {
        const int b = item >> 6, g = item & 63;
        const float* at = AT + (((size_t)(j * 64 + g) * 2 + dir) * 64 + p) * 2;
        const float ar = at[0], ai = at[1];
        const float* Eg = E + (size_t)g * S5ROWS * 256 + dir * 128 + p;
        bf16_t* Ug = UP + (size_t)g * S5ROWS * 768 + 512 + dir * 128 + p;
        float sr = 0.f, si = 0.f;
#pragma unroll 1
        for (int blk = 0; blk < 33; ++blk) {
            float er[8], ei[8]; int crs[8];
#pragma unroll
            for (int q = 0; q < 8; ++q) {
                const int s = blk * 8 + q;
                int cr;
                if (s < 8) cr = 1024 + b * 8 + (dir == 0 ? s : 7 - s);
                else cr = b * 256 + (dir == 0 ? (s - 8) : 255 - (s - 8));
                crs[q] = cr;
                er[q] = Eg[(size_t)cr * 256]; ei[q] = Eg[(size_t)cr * 256 + 64];
            }
#pragma unroll
            for (int q = 0; q < 8; ++q) {
                Ug[(size_t)crs[q] * 768] = f2bf(sr); Ug[(size_t)crs[q] * 768 + 64] = f2bf(si);
                const float nr = ar * sr - ai * si + er[q], ni = ar * si + ai * sr + ei[q];
                sr = nr; si = ni;
            }
        }
    }
}

DI bf16_t* qke_ptr(const Frame& F, int dir, int which) { return (bf16_t*)(F.ws + WS_QKE) + (size_t)(dir * 3 + which) * TT * 512; }
DI void gla_gates(const Frame& F, int j) {
    LAS float* as = (LAS float*)F.lds;
    const bf16_t* P = (const bf16_t*)(F.ws + WS_P);
    const float* ALR = (const float*)(F.ws + WS_ALR);
    float* GCH = (float*)(F.ws + WS_GCH);
    const int c = F.tid;
    for (int it = F.vcu; it < 528 * 2; it += F.G) {
        const int cg = it >> 1, dir = it & 1, row0 = cg * 64;
        __syncthreads();
        for (int idx = F.tid; idx < 1024; idx += NTHR) { const int t = idx >> 4, r = idx & 15; as[idx] = ALR[(size_t)(row0 + t) * 32 + dir * 16 + r]; }
        __syncthreads();
        float w[16];
#pragma unroll
        for (int r = 0; r < 16; ++r) w[r] = F.inp(I_WA2)[((size_t)(j * 2 + dir) * 16 + r) * 512 + c];
        const float bias = F.inp(I_BA2)[(size_t)(j * 2 + dir) * 512 + c];
        float la[64]; float tot = 0.f;
#pragma unroll
        for (int t = 0; t < 64; ++t) {
            float x = bias;
#pragma unroll
            for (int r4 = 0; r4 < 4; ++r4) { const f32x4 a = *(const LAS f32x4*)(as + t * 16 + r4 * 4); x += a[0] * w[r4 * 4] + a[1] * w[r4 * 4 + 1] + a[2] * w[r4 * 4 + 2] + a[3] * w[r4 * 4 + 3]; }
            la[t] = (fminf(x, 0.f) - __logf(1.0f + __expf(-fabsf(x)))) * (1.0f / 16.0f);
            tot += la[t];
        }
        bf16_t* QD = qke_ptr(F, dir, 0); bf16_t* KD = qke_ptr(F, dir, 1); bf16_t* KE = qke_ptr(F, dir, 2);
        float pre = 0.f;
#pragma unroll
        for (int tb = 0; tb < 4; ++tb) {
            bf16_t qv[16], kv[16];
#pragma unroll
            for (int u = 0; u < 16; ++u) { const size_t row = (size_t)(row0 + tb * 16 + u); qv[u] = P[row * 3072 + c]; kv[u] = P[row * 3072 + 512 + c]; }
#pragma unroll
            for (int u = 0; u < 16; ++u) {
                const int t = tb * 16 + u;
                pre += la[t];
                const float bq = dir == 0 ? pre : (tot - pre + la[t]);
                const float ee = tot - bq;
                const size_t row = (size_t)(row0 + t);
                const float q = bf2f(qv[u]), k = bf2f(kv[u]);
                QD[row * 512 + c] = f2bf(q * 0.08838834764831845f * __expf(bq));
                KD[row * 512 + c] = f2bf(k * __expf(-bq));
                KE[row * 512 + c] = f2bf(k * __expf(ee));
            }
        }
        GCH[((size_t)cg * 2 + dir) * 512 + c] = __expf(tot);
    }
}

constexpr int GC_XSTR = 272, GC_VSTR = 80, GC_ASTR = 144;
constexpr int GC_QD = 0, GC_KD = 64 * GC_XSTR, GC_KE = 2 * 64 * GC_XSTR, GC_V = 3 * 64 * GC_XSTR, GC_BUF = 3 * 64 * GC_XSTR + 64 * GC_VSTR;
constexpr int GC_ATT = 2 * GC_BUF, GC_S = GC_ATT + 64 * GC_ASTR;
static_assert(GC_S + 128 * GC_VSTR <= LDS_MISC, "gla chunk LDS map");
DI bf16x8 tr_frag(const LAS unsigned char* base, int stride, int k0, int c0, int lane) {
    const int q = (lane & 15) >> 2, p = lane & 3, quad = lane >> 4;
    const LAS unsigned char* a = base + (k0 + quad * 8 + q) * stride + (c0 + 4 * p) * 2;
    const s16x4 lo = __builtin_amdgcn_ds_read_tr16_b64_v4i16((LAS s16x4*)a);
    const s16x4 hi = __builtin_amdgcn_ds_read_tr16_b64_v4i16((LAS s16x4*)(a + 4 * stride));
    return __builtin_shufflevector(lo, hi, 0, 1, 2, 3, 4, 5, 6, 7);
}
constexpr int SEG_LEN = 11, SEG_N = 12;
constexpr int G2_TILE = 64 * 256;
DI int xoff(int row, int ch) { return row * 256 + 16 * (ch ^ (((row & 3) << 2) | ((row >> 2) & 3))); }
DI bf16x8 row_frag_x(const LAS unsigned char* base, int row, int k0) { return *(const LAS bf16x8*)(base + xoff(row, k0 >> 3)); }
DI bf16x8 tr_frag_x(const LAS unsigned char* base, int k0, int c0, int lane) {
    const int q = (lane & 15) >> 2, p = lane & 3, quad = lane >> 4;
    const int r0 = k0 + quad * 8 + q, ch = (c0 >> 3) + (p >> 1), bo = 8 * (p & 1);
    const s16x4 lo = __builtin_amdgcn_ds_read_tr16_b64_v4i16((LAS s16x4*)(base + xoff(r0, ch) + bo));
    const s16x4 hi = __builtin_amdgcn_ds_read_tr16_b64_v4i16((LAS s16x4*)(base + xoff(r0 + 4, ch) + bo));
    return __builtin_shufflevector(lo, hi, 0, 1, 2, 3, 4, 5, 6, 7);
}
DI int gla_rowbase(int b, int dir, int s) { return s < 4 ? TL + b * LCTX + (dir == 0 ? s : 3 - s) * 64 : b * SEQ + (dir == 0 ? (s - 4) : 127 - (s - 4)) * 64; }

DI void gla_seg_state(const Frame& F) {
    LAS unsigned char* lds = F.lds;
    const bf16_t* P = (const bf16_t*)(F.ws + WS_P);
    const float* GCH = (const float*)(F.ws + WS_GCH);
    float* SEGL = (float*)(F.ws + WS_SEGL); float* SEGG = (float*)(F.ws + WS_SEGG);
    const int tid = F.tid, lane = F.lane, w = F.wave, fr = lane & 15, quad = lane >> 4;
    constexpr int BUF = 2 * G2_TILE;
    for (int item = F.vcu; item < 32 * 11 * 2; item += F.G) {
        const int half = item & 1, seg = (item >> 1) % 11, chain = item / 22;
        const int dir = chain & 1, hd = (chain >> 1) & 3, b = chain >> 3;
        const bf16_t* KE = qke_ptr(F, dir, 2);
        f32x4 sacc[8];
#pragma unroll
        for (int t = 0; t < 8; ++t) sacc[t] = (f32x4){0.f, 0.f, 0.f, 0.f};
        f32x4 gprod = (f32x4){1.f, 1.f, 1.f, 1.f};
        u32x4 pe[2], pv[2]; f32x4 pg;
        const int xr0 = tid >> 4, xc = tid & 15;
#define S1_LOAD(u) do { const int _rb = gla_rowbase(b, dir, seg * SEG_LEN + (u)); \
        _Pragma("unroll") for (int _i = 0; _i < 2; ++_i) { pe[_i] = *(const u32x4*)(KE + (size_t)(_rb + xr0 + 32 * _i) * 512 + hd * 128 + xc * 8); \
            pv[_i] = *(const u32x4*)(P + (size_t)(_rb + xr0 + 32 * _i) * 3072 + 1024 + hd * 256 + half * 128 + xc * 8); } \
        pg = *(const f32x4*)(GCH + ((size_t)(_rb >> 6) * 2 + dir) * 512 + hd * 128 + w * 16 + quad * 4); } while (0)
#define S1_STORE(buf) do { LAS unsigned char* _b = lds + (buf) * BUF; \
        _Pragma("unroll") for (int _i = 0; _i < 2; ++_i) { const int _o = xoff(xr0 + 32 * _i, xc); *(LAS u32x4*)(_b + _o) = pe[_i]; *(LAS u32x4*)(_b + G2_TILE + _o) = pv[_i]; } } while (0)
        __syncthreads();
        S1_LOAD(0); S1_STORE(0);
        f32x4 gv = pg;
        __syncthreads();
#pragma unroll 1
        for (int u = 0; u < SEG_LEN; ++u) {
            const LAS unsigned char* be = lds + (u & 1) * BUF; const LAS unsigned char* bv = be + G2_TILE;
            const f32x4 gcur = gv;
            if (u + 1 < SEG_LEN) S1_LOAD(u + 1);
            bf16x8 af[2];
#pragma unroll
            for (int kk = 0; kk < 2; ++kk) af[kk] = tr_frag_x(be, kk * 32, w * 16, lane);
#pragma unroll
            for (int t2 = 0; t2 < 8; ++t2) {
                f32x4 sa = sacc[t2] * gcur;
#pragma unroll
                for (int kk = 0; kk < 2; ++kk) sa = __builtin_amdgcn_mfma_f32_16x16x32_bf16(af[kk], tr_frag_x(bv, kk * 32, t2 * 16, lane), sa, 0, 0, 0);
                sacc[t2] = sa;
            }
            gprod = gprod * gcur;
            if (u + 1 < SEG_LEN) { S1_STORE((u + 1) & 1); gv = pg; }
            __syncthreads();
        }
#undef S1_LOAD
#undef S1_STORE
        float* Lp = SEGL + ((size_t)(chain * 11 + seg) * 2 + half) * 16384;
#pragma unroll
        for (int t2 = 0; t2 < 8; ++t2) *(f32x4*)(Lp + ((w * 8 + t2) * 64 + lane) * 4) = sacc[t2];
        if (half == 0 && fr == 0) *(f32x4*)(SEGG + (size_t)(chain * 11 + seg) * 128 + w * 16 + quad * 4) = gprod;
    }
}

constexpr int G3_QD = 0, G3_KD = G2_TILE, G3_KE = 2 * G2_TILE, G3_V = 3 * G2_TILE, G3_ATT = 4 * G2_TILE, G3_S = G3_ATT + 64 * GC_ASTR;
constexpr int G3_O = G3_S + 2 * G2_TILE;
static_assert(G3_O + G2_TILE <= 131072, "gla seg LDS map");
DI void gla_seg_out(const Frame& F) {
    LAS unsigned char* lds = F.lds;
    const bf16_t* P = (const bf16_t*)(F.ws + WS_P);
    const float* GCH = (const float*)(F.ws + WS_GCH);
    const float* SEGL = (const float*)(F.ws + WS_SEGL); const float* SEGG = (const float*)(F.ws + WS_SEGG);
    const int tid = F.tid, lane = F.lane, w = F.wave, fr = lane & 15, quad = lane >> 4;
    for (int item = F.vcu; item < 32 * SEG_N * 2; item += F.G) {
        const int half = item & 1, seg = (item >> 1) % SEG_N, chain = item / (2 * SEG_N);
        const int dir = chain & 1, hd = (chain >> 1) & 3, b = chain >> 3;
        const bf16_t* QD = qke_ptr(F, dir, 0); const bf16_t* KD = qke_ptr(F, dir, 1); const bf16_t* KE = qke_ptr(F, dir, 2);
        bf16_t* O = (bf16_t*)(F.ws + WS_O) + (size_t)dir * TT * D;
        f32x4 sacc[8];
#pragma unroll
        for (int t = 0; t < 8; ++t) sacc[t] = (f32x4){0.f, 0.f, 0.f, 0.f};
#pragma unroll 1
        for (int gp = 0; gp < seg; ++gp) {
            const float* Lp = SEGL + ((size_t)(chain * 11 + gp) * 2 + half) * 16384;
            const f32x4 gg = *(const f32x4*)(SEGG + (size_t)(chain * 11 + gp) * 128 + w * 16 + quad * 4);
#pragma unroll
            for (int t2 = 0; t2 < 8; ++t2) sacc[t2] = sacc[t2] * gg + *(const f32x4*)(Lp + ((w * 8 + t2) * 64 + lane) * 4);
        }
        u32x4 pq[2], pk[2], pe[2], pv[2]; f32x4 pg;
        const int xr0 = tid >> 4, xc = tid & 15;
#define S2_LOAD(u) do { const int _rb = gla_rowbase(b, dir, seg * SEG_LEN + (u)); \
        _Pragma("unroll") for (int _i = 0; _i < 2; ++_i) { const size_t _o = (size_t)(_rb + xr0 + 32 * _i) * 512 + hd * 128 + xc * 8; \
            pq[_i] = *(const u32x4*)(QD + _o); pk[_i] = *(const u32x4*)(KD + _o); pe[_i] = *(const u32x4*)(KE + _o); \
            pv[_i] = *(const u32x4*)(P + (size_t)(_rb + xr0 + 32 * _i) * 3072 + 1024 + hd * 256 + half * 128 + xc * 8); } \
        pg = *(const f32x4*)(GCH + ((size_t)(_rb >> 6) * 2 + dir) * 512 + hd * 128 + w * 16 + quad * 4); } while (0)
#define S2_STORE() do { _Pragma("unroll") for (int _i = 0; _i < 2; ++_i) { const int _o = xoff(xr0 + 32 * _i, xc); \
            *(LAS u32x4*)(lds + G3_QD + _o) = pq[_i]; *(LAS u32x4*)(lds + G3_KD + _o) = pk[_i]; *(LAS u32x4*)(lds + G3_KE + _o) = pe[_i]; *(LAS u32x4*)(lds + G3_V + _o) = pv[_i]; } } while (0)
        __syncthreads();
        S2_LOAD(0); S2_STORE();
        f32x4 gv = pg;
#pragma unroll
        for (int t2 = 0; t2 < 8; ++t2)
#pragma unroll
            for (int r = 0; r < 4; ++r) *(LAS bf16_t*)(lds + G3_S + xoff(w * 16 + quad * 4 + r, t2 * 2 + (fr >> 3)) + (fr & 7) * 2) = f2bf(sacc[t2][r]);
        __syncthreads();
        const int tm = w >> 1, tn0 = (w & 1) * 4;
#pragma unroll 1
        for (int u = 0; u < SEG_LEN; ++u) {
            const int rb = gla_rowbase(b, dir, seg * SEG_LEN + u);
            const f32x4 gcur = gv;
            if (u + 1 < SEG_LEN) S2_LOAD(u + 1);
#pragma unroll
            for (int q2 = 0; q2 < 2; ++q2) {
                const int id = 2 * w + q2, ti = id >> 2, tj = id & 3;
                f32x4 a4 = (f32x4){0.f, 0.f, 0.f, 0.f};
#pragma unroll
                for (int kk = 0; kk < 4; ++kk) {
                    const bf16x8 af = row_frag_x(lds + G3_QD, ti * 16 + fr, kk * 32 + quad * 8);
                    const bf16x8 bf = row_frag_x(lds + G3_KD, tj * 16 + fr, kk * 32 + quad * 8);
                    a4 = __builtin_amdgcn_mfma_f32_16x16x32_bf16(af, bf, a4, 0, 0, 0);
                }
                const int jcol = tj * 16 + fr;
#pragma unroll
                for (int r = 0; r < 4; ++r) { const int irow = ti * 16 + quad * 4 + r; const bool keep = dir == 0 ? (jcol <= irow) : (jcol >= irow);
                    *(LAS bf16_t*)(lds + G3_ATT + irow * GC_ASTR + jcol * 2) = f2bf(keep ? a4[r] : 0.f); }
            }
            f32x4 oacc[4];
#pragma unroll
            for (int t = 0; t < 4; ++t) oacc[t] = (f32x4){0.f, 0.f, 0.f, 0.f};
#pragma unroll
            for (int kk = 0; kk < 4; ++kk) {
                const bf16x8 af = row_frag_x(lds + G3_QD, tm * 16 + fr, kk * 32 + quad * 8);
#pragma unroll
                for (int t = 0; t < 4; ++t) oacc[t] = __builtin_amdgcn_mfma_f32_16x16x32_bf16(af, tr_frag_x(lds + G3_S, kk * 32, (tn0 + t) * 16, lane), oacc[t], 0, 0, 0);
            }
            __syncthreads();
#pragma unroll
            for (int kk = 0; kk < 2; ++kk) {
                const bf16x8 af = *(const LAS bf16x8*)(lds + G3_ATT + (tm * 16 + fr) * GC_ASTR + (kk * 32 + quad * 8) * 2);
#pragma unroll
                for (int t = 0; t < 4; ++t) oacc[t] = __builtin_amdgcn_mfma_f32_16x16x32_bf16(af, tr_frag_x(lds + G3_V, kk * 32, (tn0 + t) * 16, lane), oacc[t], 0, 0, 0);
            }
#pragma unroll
            for (int t = 0; t < 4; ++t)
#pragma unroll
                for (int r = 0; r < 4; ++r) *(LAS bf16_t*)(lds + G3_O + (tm * 16 + quad * 4 + r) * 256 + ((tn0 + t) * 16 + fr) * 2) = f2bf(oacc[t][r]);
            {
                bf16x8 af[2];
#pragma unroll
                for (int kk = 0; kk < 2; ++kk) af[kk] = tr_frag_x(lds + G3_KE, kk * 32, w * 16, lane);
#pragma unroll
                for (int t2 = 0; t2 < 8; ++t2) {
                    f32x4 sa = sacc[t2] * gcur;
#pragma unroll
                    for (int kk = 0; kk < 2; ++kk) sa = __builtin_amdgcn_mfma_f32_16x16x32_bf16(af[kk], tr_frag_x(lds + G3_V, kk * 32, t2 * 16, lane), sa, 0, 0, 0);
                    sacc[t2] = sa;
                }
            }
            __syncthreads();
#pragma unroll
            for (int _i = 0; _i < 2; ++_i) *(u32x4*)(O + (size_t)(rb + xr0 + 32 * _i) * D + hd * 256 + half * 128 + xc * 8) = *(const LAS u32x4*)(lds + G3_O + (xr0 + 32 * _i) * 256 + xc * 16);
            if (u + 1 < SEG_LEN) {
                S2_STORE(); gv = pg;
#pragma unroll
                for (int t2 = 0; t2 < 8; ++t2)
#pragma unroll
                    for (int r = 0; r < 4; ++r) *(LAS bf16_t*)(lds + G3_S + xoff(w * 16 + quad * 4 + r, t2 * 2 + (fr >> 3)) + (fr & 7) * 2) = f2bf(sacc[t2][r]);
            }
            __syncthreads();
        }
#undef S2_LOAD
#undef S2_STORE
    }
}

DI void gla_prep(const Frame& F, int j) {
    const bf16_t* OF = (const bf16_t*)(F.ws + WS_O); const bf16_t* OB = OF + (size_t)TT * D;
    const bf16_t* P = (const bf16_t*)(F.ws + WS_P);
    bf16_t* YG = (bf16_t*)(F.ws + WS_YG);
    const int lane = F.lane;
    const f32x4 ng = *(const f32x4*)(F.inp(I_NORMG) + (size_t)j * 256 + 4 * lane);
    for (int row = F.vcu * 8 + F.wave; row < TT; row += F.G * 8) {
#pragma unroll
        for (int i = 0; i < 4; ++i) {
            const size_t o = (size_t)row * D + 256 * i + 4 * lane;
            const u32x2 a = *(const u32x2*)(OF + o), bb = *(const u32x2*)(OB + o);
            const u32x2 gg = *(const u32x2*)(P + (size_t)row * 3072 + 2048 + 256 * i + 4 * lane);
            f32x4 v; v[0] = bf_lo(a[0]) + bf_lo(bb[0]); v[1] = bf_hi(a[0]) + bf_hi(bb[0]); v[2] = bf_lo(a[1]) + bf_lo(bb[1]); v[3] = bf_hi(a[1]) + bf_hi(bb[1]);
            const float ms = wave_sum(v[0] * v[0] + v[1] * v[1] + v[2] * v[2] + v[3] * v[3]) * (1.0f / 256.0f);
            const float rs = rsqrtf(ms + LN_EPS);
            f32x4 g4; g4[0] = bf_lo(gg[0]); g4[1] = bf_hi(gg[0]); g4[2] = bf_lo(gg[1]); g4[3] = bf_hi(gg[1]);
            f32x4 y;
#pragma unroll
            for (int q = 0; q < 4; ++q) y[q] = v[q] * rs * ng[q] * (g4[q] * sigmoidf_(g4[q]));
            u32x2 p; p[0] = cvt_pk_bf16(y[0], y[1]); p[1] = cvt_pk_bf16(y[2], y[3]);
            *(u32x2*)(YG + o) = p;
        }
    }
}

#ifndef DUP_MASK
#define DUP_MASK 0
#endif
#ifndef DRY_DUP
#define DRY_DUP 0
#endif
#ifndef OFF_MASK
#define OFF_MASK 0
#endif
#define DUPN(id) (((OFF_MASK >> (id)) & 1) ? 0 : ((DUP_MASK >> (id)) & 1 ? 2 : 1))
#ifndef STOP_AT
#define STOP_AT 0
#endif
DI void dump_h(const Frame& F) {
    const u32x2* H = (const u32x2*)(F.ws + WS_H); f32x4* O = (f32x4*)F.out;
    for (size_t i = (size_t)F.vcu * NTHR + F.tid; i < (size_t)TL * D / 4; i += (size_t)F.G * NTHR) { const u32x2 h = H[i]; O[i] = (f32x4){h_lo(h[0]), h_hi(h[0]), h_lo(h[1]), h_hi(h[1])}; }
}
#define STOP_CHECK(code) do { if (STOP_AT == (code)) { const Frame L = launder(F); dump_h(L); return; } } while (0)
#ifdef PROBE
#define STAMP(id) do { if (blockIdx.x == 0 && threadIdx.x == 0) { const unsigned long long _n = __builtin_amdgcn_s_memrealtime(); volatile LAS unsigned* _d = (volatile LAS unsigned*)(F.lds + LDS_MISC + 512); \
    _d[(id)] += (unsigned)(_n - *(volatile LAS unsigned long long*)(F.lds + LDS_MISC + 768)); *(volatile LAS unsigned long long*)(F.lds + LDS_MISC + 768) = _n; } } while (0)
#else
#define STAMP(id) do { } while (0)
#endif
__global__ void __launch_bounds__(NTHR, 2) fwd_kernel(Args args) {
    extern __shared__ __attribute__((aligned(16))) unsigned char lds_raw[];
    Frame F;
    F.lds = (LAS unsigned char*)lds_raw; F.ws = args.ws; F.in = (inarr_t)__builtin_amdgcn_kernarg_segment_ptr(); F.out = args.out;
    F.tid = threadIdx.x; F.lane = F.tid & 63; F.wave = __builtin_amdgcn_readfirstlane(F.tid >> 6);
    F.G = gridDim.x; { const int bx = blockIdx.x; F.vcu = (F.G % 8 == 0) ? (bx % 8) * (F.G / 8) + bx / 8 : bx; }
    for (int u = F.tid; u < 1024 / 4; u += NTHR) ((LAS unsigned*)(F.lds + LDS_MISC))[u] = 0u;
    __syncthreads();
    F.ws = (unsigned char*)(GBL unsigned char*)(unsigned long long)F.ws; F.out = (float*)(GBL float*)(unsigned long long)F.out;
    XcdBarrier bar = xcd_barrier_post((unsigned*)(F.ws + WS_CTL), (volatile LAS unsigned*)(F.lds + LDS_MISC));
#define GRID_BAR_() do { XcdBarrier _b = bar; { unsigned long long _x = (unsigned long long)_b.bar; asm volatile("" : "+s"(_x)); _b.bar = (unsigned*)(GBL unsigned*)_x; } asm volatile("" : "+s"(_b.x)); xcd_barrier(_b); } while (0)
#define GRID_BAR(id) do { GRID_BAR_(); STAMP(id); } while (0)
#ifdef PROBE
    if (blockIdx.x == 0 && threadIdx.x == 0) *(volatile LAS unsigned long long*)(F.lds + LDS_MISC + 768) = __builtin_amdgcn_s_memrealtime();
#endif
    LAS int* mt = (LAS int*)(F.lds + 131072);
    if (F.tid == 0) *(volatile LAS int*)(F.lds + LDS_MISC + 72) = (int)__hip_atomic_fetch_add((unsigned*)(F.ws + WS_CTL) + CW_XRANK + bar.x, 1u, __ATOMIC_RELAXED, __HIP_MEMORY_SCOPE_AGENT);
    volatile LAS int* qslot = (volatile LAS int*)(F.lds + LDS_MISC + 64);

    for (int _r = 0; _r < DUPN(0); ++_r) { if (_r) GRID_BAR(0);
    for (;;) {
        const Frame L = launder(F);
        __syncthreads();
        if (L.tid == 0) *qslot = (int)__hip_atomic_fetch_add((unsigned*)(L.ws + WS_CTL) + CW_QUEUE + 32 * _r, 1u, __ATOMIC_RELAXED, __HIP_MEMORY_SCOPE_AGENT);
        __syncthreads();
        const int q = __builtin_amdgcn_readfirstlane(*qslot);
        if (q < PI_S5 + PI_MOD) { prologue_item(L, q); continue; }
        const int base = PI_S5 + PI_MOD + (q - (PI_S5 + PI_MOD)) * 16;
        if (base >= PI_TOTAL) break;
        transpose_batch(L, base - (PI_S5 + PI_MOD), (PI_TOTAL - base) < 16 ? (PI_TOTAL - base) : 16);
    }
    }
    GRID_BAR(0);
    {
        if (F.tid == 0) { const unsigned* cen = (const unsigned*)(F.ws + WS_CTL); int pre = 0; for (unsigned jx = 0; jx < bar.x; ++jx) pre += (int)cen[XB_XCNT(jx)];
            *(volatile LAS int*)(F.lds + LDS_MISC + 76) = pre + *(volatile LAS int*)(F.lds + LDS_MISC + 72); }
        __syncthreads();
        F.vcu = __builtin_amdgcn_readfirstlane(*(volatile LAS int*)(F.lds + LDS_MISC + 76));
    }
if (DUPN(1))     { const Frame L = launder(F); row_pass<IN_INIT, OUT_S5>(L, TT, 0, nullptr, nullptr, 0, 0, nullptr, nullptr, 0); }
    GRID_BAR(1);
#pragma unroll 1
    for (int layer = 0; layer < DEPTH; ++layer) {
        const int j = layer >> 1;
        if ((layer & 1) == 0) {
for (int _r = 0; _r < DUPN(2); ++_r) { if (_r) GRID_BAR(2);
            { const Frame L = launder(F); ProbS5E p{(const bf16_t*)(L.ws + WS_UP), (const bf16_t*)(L.ws + WS_S5PIN) + (size_t)j * 64 * 256 * 512, (float*)(L.ws + WS_E), L.G, L.vcu}; g8::gemm_phase(L.lds, L.tid, p); }
}
            GRID_BAR(2);
for (int _r = 0; _r < DUPN(3); ++_r) { if (_r) GRID_BAR(3);
            { const Frame L = launder(F); s5_scan(L, j); }
}
            GRID_BAR(3);
for (int _r = 0; _r < DUPN(4); ++_r) { if (_r) GRID_BAR(4);
            { const Frame L = launder(F); ProbS5Y p{(const bf16_t*)(L.ws + WS_UP), (const bf16_t*)(L.ws + WS_S5M) + (size_t)j * 64 * 512 * 768, (bf16_t*)(L.ws + WS_YG), L.G, L.vcu}; g8::gemm_phase(L.lds, L.tid, p); }
}
            GRID_BAR(4);
if (DUPN(5))             { const Frame L = launder(F); ProbGLU p{(const bf16_t*)(L.ws + WS_YG), (const bf16_t*)(L.ws + WS_WGLU) + (size_t)j * 2048 * 1024, (bf16_t*)(L.ws + WS_H), (const float*)(L.ws + WS_MOD) + (size_t)layer * 5 * 6144, L.G, L.vcu}; g8::gemm_phase(L.lds, L.tid, p); }
        } else {
for (int _r = 0; _r < DUPN(10); ++_r) { if (_r) GRID_BAR(10);
            { const Frame L = launder(F); ProbProj p{(const bf16_t*)(L.ws + WS_UB), (const bf16_t*)(L.ws + WS_WIN) + (size_t)j * 3072 * 1024, (bf16_t*)(L.ws + WS_P), L.G, L.vcu}; g8::gemm_phase(L.lds, L.tid, p); }
}
            GRID_BAR(10);
for (int _r = 0; _r < DUPN(11); ++_r) { if (_r) GRID_BAR(11);
            { const Frame L = launder(F); gla_gates(L, j); }
}
            GRID_BAR(11);
for (int _r = 0; _r < DUPN(12); ++_r) { if (_r) GRID_BAR(12);
            { const Frame L = launder(F); gla_seg_state(L); }
            GRID_BAR(12);
            { const Frame L = launder(F); gla_seg_out(L); }
}
            GRID_BAR(12);
for (int _r = 0; _r < DUPN(13); ++_r) { if (_r) GRID_BAR(13);
            { const Frame L = launder(F); gla_prep(L, j); }
}
            GRID_BAR(13);
if (DUPN(14))             { const Frame L = launder(F); ProbOut p{(const bf16_t*)(L.ws + WS_YG), (const bf16_t*)(L.ws + WS_WOUT) + (size_t)j * 1024 * 1024, (bf16_t*)(L.ws + WS_H), (const float*)(L.ws + WS_MOD) + (size_t)layer * 5 * 6144, layer == 3 ? TL / 256 : TT / 256, L.G, L.vcu}; g8::gemm_phase(L.lds, L.tid, p); }
        }
        GRID_BAR((layer & 1) ? 14 : 5);
        if (DUPN(6)) { const Frame L = launder(F);
          row_pass<IN_LN, OUT_ROUTER>(L, layer == 3 ? TL : TT, layer, L.inp(I_LN1G) + (size_t)layer * D, L.inp(I_LN1B) + (size_t)layer * D, layer, 3,
                                      (const bf16_t*)(L.ws + WS_WR) + (size_t)layer * 32 * 1024, L.inp(I_BROUTER) + (size_t)layer * 32, layer); }
        GRID_BAR(6);
        if (STOP_AT != 0 && STOP_AT == layer * 2 + 1) { const Frame L = launder(F); dump_h(L); return; }
for (int _r = 0; _r < DUPN(7); ++_r) { if (_r) GRID_BAR(7);
        { const Frame L = launder(F);
          __syncthreads();
          if (L.tid == 0) { const unsigned* cw = (const unsigned*)(L.ws + WS_CTL) + CW_CNT + layer * 32; int acc = 0; mt[32] = 0; for (int e = 0; e < 32; ++e) { const int c = (int)cw[e]; mt[e] = c; acc += (c + 255) >> 8; mt[33 + e] = acc; } }
          __syncthreads();
          for (int T = L.tid; T < mt[64]; T += NTHR) { int e = 0; for (int q = 1; q < 32; ++q) e += (T >= mt[32 + q]) ? 1 : 0; ((LAS unsigned char*)(mt + 80))[T] = (unsigned char)e; }
          __syncthreads();
          ProbUp p{L.ws + WS_UB8, L.ws + WS_WUP + (size_t)layer * 32 * 2048 * 1024, L.inp(I_BUP) + (size_t)layer * 32 * 2048, (const int*)(L.ws + WS_TOKL),
                   L.ws + WS_ACT, MoeTab{mt}, L.G, L.vcu, (DRY_DUP && _r) ? 1 : 0}; g8::gemm_phase(L.lds, L.tid, p); }
}
        GRID_BAR(7);
for (int _r = 0; _r < DUPN(8); ++_r) { if (_r) GRID_BAR(8);
        { const Frame L = launder(F);
          ProbDown p{L.ws + WS_ACT, L.ws + WS_WDN + (size_t)layer * 32 * 1024 * 1024, L.inp(I_BDN) + (size_t)layer * 32 * 1024, (const int*)(L.ws + WS_TOKL),
                     (const float*)(L.ws + WS_GATEL), (bf16_t*)(L.ws + WS_FEXP), MoeTab{mt}, L.G, L.vcu, (DRY_DUP && _r) ? 1 : 0}; g8::gemm_phase(L.lds, L.tid, p); }
}
        GRID_BAR(8);
        if (DUPN(9)) { const Frame L = launder(F);
          const float* l2g = L.inp(I_LN2G) + (size_t)layer * D; const float* l2b = L.inp(I_LN2B) + (size_t)layer * D;
          if (layer == 3) row_pass<IN_COMBINE, OUT_FINAL>(L, TL, layer, l2g, l2b, 0, 0, nullptr, nullptr, 0);
          else if (layer & 1) row_pass<IN_COMBINE, OUT_S5>(L, TT, layer, l2g, l2b, layer + 1, 0, nullptr, nullptr, 0);
          else row_pass<IN_COMBINE, OUT_CMLR>(L, TT, layer, l2g, l2b, layer + 1, 0, (const bf16_t*)(L.ws + WS_WLR) + (size_t)((layer + 1) >> 1) * 32 * 1024, nullptr, 0); }
        if (layer < 3) GRID_BAR(9);
#ifdef PROBE
        else GRID_BAR(9);
#endif
        if (STOP_AT != 0 && STOP_AT == layer * 2 + 2) { const Frame L = launder(F); dump_h(L); return; }
    }
#ifdef PROBE
    {
        unsigned* pw = (unsigned*)(F.ws + WS_CTL) + 4096;
        if (blockIdx.x == 0 && threadIdx.x == 0) { volatile LAS unsigned* d = (volatile LAS unsigned*)(F.lds + LDS_MISC + 512); pw[0] = d[PROBE_A]; pw[1] = d[PROBE_B]; }
        GRID_BAR_();
        const float va = sqrtf((float)pw[0] * 0.01f * (float)(PROBE_SA)), vb = (float)pw[1] * 0.01f * (float)(PROBE_SB);
        f32x4* O = (f32x4*)F.out;
        for (size_t i = (size_t)blockIdx.x * NTHR + threadIdx.x; i < (size_t)TL * D / 4; i += (size_t)gridDim.x * NTHR) { f32x4 v = (f32x4){va, va, va, va}; if (i == 0) v[0] = vb; O[i] = v; }
    }
#endif
}

extern "C" void kernel_launch(void* const* d_in, const int* in_sizes, int n_in, void* d_out, int out_size, void* d_ws, size_t ws_size, hipStream_t stream) {
    static int grid = 0;
    if (grid == 0) {
        if (n_in != 30 || out_size != TL * D || ws_size < WS_END) { fprintf(stderr, "kernel_launch: unexpected shapes (n_in %d out %d ws %zu need %zu)\n", n_in, out_size, ws_size, (size_t)WS_END); grid = -1; return; }
        int dev = 0, cus = 0, per_cu = 0;
        if (hipGetDevice(&dev) != hipSuccess || hipDeviceGetAttribute(&cus, hipDeviceAttributeMultiprocessorCount, dev) != hipSuccess) { grid = -1; return; }
        if (hipFuncSetAttribute((const void*)fwd_kernel, hipFuncAttributeMaxDynamicSharedMemorySize, LDS_BYTES) != hipSuccess) { fprintf(stderr, "kernel_launch: hipFuncSetAttribute failed\n"); grid = -1; return; }
        if (hipOccupancyMaxActiveBlocksPerMultiprocessor(&per_cu, (const void*)fwd_kernel, NTHR, LDS_BYTES) != hipSuccess || per_cu < 1) { fprintf(stderr, "kernel_launch: occupancy query says %d\n", per_cu); }
        (void)hipGetLastError();
        grid = cus;
    }
    if (grid < 0) return;
    (void)in_sizes;
    if (hipMemsetAsync((char*)d_ws + WS_CTL, 0, CTL_BYTES, stream) != hipSuccess) return;
    Args a{};
    for (int i = 0; i < 30; ++i) a.in[i] = (const float*)d_in[i];
    a.out = (float*)d_out; a.ws = (unsigned char*)d_ws;
    hipLaunchKernelGGL(fwd_kernel, dim3(grid), dim3(NTHR), LDS_BYTES, stream, a);
}
```
